# Optimizing an MI355X kernel written in HIP

```python
import jax, jax.numpy as jnp
from jax import lax
import numpy as np

D_MODEL = 1024
BATCH = 4
SEQ = 8192
DEPTH = 1

HGRN_HEADS = 8
HGRN_HEAD_DIM = 128
D_A = HGRN_HEADS * HGRN_HEAD_DIM
CHUNK = 64
D_B = D_MODEL
CONV_WIDTH = 31
D_FF = 4 * D_MODEL
EPS = 1e-6

SPLITS = (D_A, 2 * D_A, 3 * D_A, 4 * D_A, 4 * D_A + 2 * D_B, 4 * D_A + 2 * D_B + D_MODEL)
D_IN = 4 * D_A + 2 * D_B + 2 * D_MODEL

kernel_name = "hgrn2_conformer_gated_hybrid"


def rms_norm(x, g):
    xf = x.astype(jnp.float32)
    y = xf * lax.rsqrt(jnp.mean(xf * xf, axis=-1, keepdims=True) + EPS)
    return (y * g.astype(jnp.float32)).astype(x.dtype)


def layer_norm(x, g, b):
    xf = x.astype(jnp.float32)
    mu = jnp.mean(xf, axis=-1, keepdims=True)
    xc = xf - mu
    var = jnp.mean(xc * xc, axis=-1, keepdims=True)
    y = xc * lax.rsqrt(var + EPS) * g.astype(jnp.float32) + b.astype(jnp.float32)
    return y.astype(x.dtype)


def hgrn2_chunked(q, k, v, log_f):
    B, S, H, dk = q.shape
    dv = v.shape[-1]
    n = S // CHUNK

    def to_chunks(t):
        return t.reshape(B, n, CHUNK, H, t.shape[-1]).transpose(1, 0, 3, 2, 4)

    causal = jnp.tril(jnp.ones((CHUNK, CHUNK), dtype=bool))

    def step(state, inp):
        qc, kc, vc, lf = inp
        b = jnp.cumsum(lf, axis=2)
        o_inter = jnp.einsum('bhtd,bhdv->bhtv', qc * jnp.exp(b), state)
        diff = b[:, :, :, None, :] - b[:, :, None, :, :]
        decay = jnp.exp(jnp.where(causal[None, None, :, :, None], diff, -jnp.inf))
        scores = jnp.einsum('bhtd,bhsd,bhtsd->bhts', qc, kc, decay)
        o_intra = jnp.einsum('bhts,bhsv->bhtv', scores, vc)
        b_last = b[:, :, -1:, :]
        k_dec = kc * jnp.exp(b_last - b)
        new_state = (jnp.exp(b_last[:, :, 0, :])[..., None] * state
                     + jnp.einsum('bhsd,bhsv->bhdv', k_dec, vc))
        return new_state, o_inter + o_intra

    s0 = jnp.zeros((B, H, dk, dv), jnp.float32)
    _, o = lax.scan(step, s0, (to_chunks(q), to_chunks(k), to_chunks(v), to_chunks(log_f)))
    return o.transpose(1, 0, 3, 2, 4).reshape(B, S, H, dv)


def causal_depthwise_conv(u, w, b):
    y = lax.conv_general_dilated(
        u, w[:, None, :].astype(u.dtype), window_strides=(1,),
        padding=[(CONV_WIDTH - 1, 0)],
        dimension_numbers=('NWC', 'WIO', 'NWC'),
        feature_group_count=u.shape[-1])
    return y + b.astype(u.dtype)


def setup_inputs(seed: int = 0) -> dict:
    key = jax.random.key(seed)
    ks = jax.random.split(key, 16)
    f32 = jnp.float32

    def nrm(k, shape, scale):
        return jax.random.normal(k, shape, f32) * scale

    return {
        "x": nrm(ks[0], (BATCH, SEQ, D_MODEL), 1.0),
        "norm_mix_g": 1.0 + nrm(ks[1], (DEPTH, D_MODEL), 0.02),
        "w_in": nrm(ks[2], (DEPTH, D_MODEL, D_IN), D_MODEL ** -0.5),
        "lb_param": nrm(ks[3], (DEPTH + 1, D_A), 0.5),
        "hgrn_norm_g": 1.0 + nrm(ks[4], (DEPTH, HGRN_HEAD_DIM), 0.02),
        "w_a_out": nrm(ks[5], (DEPTH, D_A, D_MODEL), D_A ** -0.5),
        "conv_w": nrm(ks[6], (DEPTH, CONV_WIDTH, D_B), CONV_WIDTH ** -0.5),
        "conv_b": nrm(ks[7], (DEPTH, D_B), 0.02),
        "conv_ln_g": 1.0 + nrm(ks[8], (DEPTH, D_B), 0.02),
        "conv_ln_b": nrm(ks[9], (DEPTH, D_B), 0.02),
        "w_b_out": nrm(ks[10], (DEPTH, D_B, D_MODEL), D_B ** -0.5),
        "w_out": nrm(ks[11], (DEPTH, D_MODEL, D_MODEL), D_MODEL ** -0.5),
        "norm_mlp_g": 1.0 + nrm(ks[12], (DEPTH, D_MODEL), 0.02),
        "w_mlp_in": nrm(ks[13], (DEPTH, D_MODEL, D_FF), D_MODEL ** -0.5),
        "w_mlp_out": nrm(ks[14], (DEPTH, D_FF, D_MODEL), D_FF ** -0.5),
        "norm_final_g": 1.0 + nrm(ks[15], (D_MODEL,), 0.02),
    }


def reference(x, norm_mix_g, w_in, lb_param, hgrn_norm_g, w_a_out, conv_w, conv_b,
              conv_ln_g, conv_ln_b, w_b_out, w_out, norm_mlp_g, w_mlp_in, w_mlp_out,
              norm_final_g):
    B, S, _ = x.shape
    dt = x.dtype
    lb_all = jnp.cumsum(jax.nn.softmax(lb_param.astype(jnp.float32), axis=0), axis=0)

    for l in range(DEPTH):
        h = rms_norm(x, norm_mix_g[l])
        proj = jnp.einsum('bsd,de->bse', h, w_in[l])
        q, f_logit, i_in, g_out, glu_in, gate_a, gate_b = jnp.split(proj, SPLITS, axis=-1)

        lb = lb_all[l]
        zf = f_logit.astype(jnp.float32)
        log_f = jnp.log(lb + (1.0 - lb) * jax.nn.sigmoid(zf))
        k_in = (1.0 - lb) * jax.nn.sigmoid(-zf)
        hd = (B, S, HGRN_HEADS, HGRN_HEAD_DIM)
        o_a = hgrn2_chunked(jax.nn.silu(q.astype(jnp.float32)).reshape(hd),
                            k_in.reshape(hd), i_in.astype(jnp.float32).reshape(hd),
                            log_f.reshape(hd))
        o_a = rms_norm(o_a, hgrn_norm_g[l]).reshape(B, S, D_A).astype(dt)
        o_a = o_a * jax.nn.silu(g_out)
        branch_a = jnp.einsum('bse,ed->bsd', o_a, w_a_out[l])

        glu_a, glu_b = jnp.split(glu_in, 2, axis=-1)
        u = glu_a * jax.nn.sigmoid(glu_b)
        u = causal_depthwise_conv(u, conv_w[l], conv_b[l])
        u = jax.nn.silu(layer_norm(u, conv_ln_g[l], conv_ln_b[l]))
        branch_b = jnp.einsum('bsc,cd->bsd', u, w_b_out[l])

        merged = jax.nn.sigmoid(gate_a) * branch_a + jax.nn.sigmoid(gate_b) * branch_b
        x = x + jnp.einsum('bsd,de->bse', merged, w_out[l])

        h2 = rms_norm(x, norm_mlp_g[l])
        z = jax.nn.relu(jnp.einsum('bsd,df->bsf', h2, w_mlp_in[l]))
        x = x + jnp.einsum('bsf,fd->bsd', z * z, w_mlp_out[l])

    return rms_norm(x, norm_final_g)
```

```cpp
#include <hip/hip_runtime.h>
#include <hip/hip_cooperative_groups.h>
#include <cstdio>
#include <cstdint>
namespace pg8 {
#define PG8_LAS __attribute__((address_space(3)))
typedef unsigned short bf16_t;
typedef short bf16x8 __attribute__((ext_vector_type(8)));
typedef float f32x4 __attribute__((ext_vector_type(4)));
typedef unsigned u32x4 __attribute__((ext_vector_type(4)));
constexpr int BM = 256, BK = 64, HALF = 128, HTB = HALF * BK * 2  , STAGE_BYTES = 8 * HTB, NXCD = 8, WGM = 2;

__host__ __device__ __forceinline__ int lds_byte(int r, int c) { const int st = (r >> 4) * 2 + (c >> 5), rr = r & 15, cc = c & 31, ob = rr * 64 + cc * 2; return st * 1024 + (ob ^ (((ob >> 9) & 1) << 5)); }
__host__ __device__ __forceinline__ void stage_rc(int b, int& R, int& C) { const int st = b / 1024, sb = b % 1024, swz = sb ^ (((sb >> 9) & 1) << 5); R = (st >> 1) * 16 + swz / 64; C = (st & 1) * 32 + (swz % 64) / 2; }
__host__ __device__ __forceinline__ int perm32(int rho) { const int n = rho >> 4, i = rho & 15; return 8 * (i >> 2) + 4 * n + (i & 3); }

struct Unit { int pm, pn; };
struct Gemm { const bf16_t* A; const bf16_t* Bt; int M, N, K; int ld, split_kt; long splitA, splitB; };

struct StaticOrder {
    int nM, nN, nwg, G, c, wgm, rot;
    __host__ __device__ void init(int M, int N, int G_, int c_, int wgm_ = WGM) { nM = M / BM; nN = N / BM; nwg = nM * nN; G = G_; c = c_; wgm = wgm_; rot = 0; }
    __host__ __device__ bool next(int i, Unit& u) const {
        const long L = (long)i * G + c; if (L >= nwg) return false;
        int wgid = (int)L; { const int q = nwg / NXCD, r = nwg % NXCD, xcd = wgid % NXCD, off = wgid / NXCD; wgid = (xcd < r ? xcd * (q + 1) : r * (q + 1) + (xcd - r) * q) + off; }
        const int nig = wgm * nN, gid = wgid / nig, fm = gid * wgm, gsz = (nM - fm) < wgm ? (nM - fm) : wgm;
        u.pm = fm + ((wgid % nig) % gsz); u.pn = (wgid % nig) / gsz; if (rot) u.pn = (u.pn & ~15) | ((u.pn + rot * gid) & 15); return true;
    }
    __device__ __forceinline__ void a_ready(const Unit&) const {}
    __device__ __forceinline__ void done(const Unit&) const {}
};

__device__ __forceinline__ unsigned cvt_pk_bf16(float lo, float hi) { unsigned r; asm volatile("v_cvt_pk_bf16_f32 %0, %1, %2" : "=v"(r) : "v"(lo), "v"(hi)); return r; }
typedef float f32x2 __attribute__((ext_vector_type(2)));

typedef unsigned u32x2 __attribute__((ext_vector_type(2)));
typedef _Float16 f16x2 __attribute__((ext_vector_type(2)));
__device__ __forceinline__ unsigned pk_f16(float a, float b) { f16x2 v; v.x = (_Float16)a; v.y = (_Float16)b; return __builtin_bit_cast(unsigned, v); }
__device__ __forceinline__ float bf_lo(unsigned w) { return __uint_as_float(w << 16); }
__device__ __forceinline__ float bf_hi(unsigned w) { return __uint_as_float(w & 0xffff0000u); }
template <class V> __device__ __forceinline__ void st_nt(V* p, V v) { __builtin_nontemporal_store(v, p); }
__device__ __forceinline__ float sigm(float z) { return __builtin_amdgcn_rcpf(1.0f + __builtin_amdgcn_exp2f(-1.4426950409f * z)); }
__device__ __forceinline__ f32x2 exp2n2(f32x2 z) { const f32x2 t = z * (-1.4426950409f); f32x2 e; e.x = __builtin_amdgcn_exp2f(t.x); e.y = __builtin_amdgcn_exp2f(t.y); return e; }
__device__ __forceinline__ f32x2 rcp2(f32x2 d) { f32x2 r; r.x = __builtin_amdgcn_rcpf(d.x); r.y = __builtin_amdgcn_rcpf(d.y); return r; }
__device__ __forceinline__ f32x2 sigm2(f32x2 z) { return rcp2(exp2n2(z) + 1.0f); }
__device__ __forceinline__ f32x4 sigm4(f32x4 z) { const f32x2 lo = sigm2(__builtin_shufflevector(z, z, 0, 1)), hi = sigm2(__builtin_shufflevector(z, z, 2, 3)); return (f32x4){lo.x, lo.y, hi.x, hi.y}; }

struct EpiIn {
    static constexpr bool PERM = true, AFTER_DRAIN = false, HAS_MID = false; static constexpr int AUX_A = 0;
    bf16_t *Q, *KK, *V, *GS, *U, *GA, *GB; bf16_t* LF; const float* LB;
    __device__ __forceinline__ void operator()(const f32x4 (&acc)[2][2][4][2], const Unit& u, int wr, int wc, int fr, int fq) const {
        const int row0 = u.pm * BM + wr * 64 + fr; const int type = u.pn >> 2;
        if (type >= 6) {
            const int col = 128 * (u.pn - 24) + wc * 32 + 8 * fq;
#pragma unroll
            for (int ai = 0; ai < 2; ++ai)
#pragma unroll
                for (int m = 0; m < 4; ++m) { const size_t off = (size_t)(row0 + ai * HALF + m * 16) * 1024 + col; float rr[8], gb[8];
#pragma unroll
                    for (int n = 0; n < 2; ++n)
#pragma unroll
                        for (int j = 0; j < 4; j += 2) { const f32x4 za = acc[ai][0][m][n], zb = acc[ai][1][m][n];
                            const f32x2 da = exp2n2((f32x2){za[j], za[j + 1]}) + 1.0f, db = exp2n2((f32x2){zb[j], zb[j + 1]}) + 1.0f;
                            const f32x2 r2 = db * rcp2(da), g2 = rcp2(db);
                            rr[4 * n + j] = r2.x; rr[4 * n + j + 1] = r2.y; gb[4 * n + j] = g2.x; gb[4 * n + j + 1] = g2.y; }
                    u32x4 wr_, wg; wr_.x = cvt_pk_bf16(rr[0], rr[1]); wr_.y = cvt_pk_bf16(rr[2], rr[3]); wr_.z = cvt_pk_bf16(rr[4], rr[5]); wr_.w = cvt_pk_bf16(rr[6], rr[7]);
                    wg.x = cvt_pk_bf16(gb[0], gb[1]); wg.y = cvt_pk_bf16(gb[2], gb[3]); wg.z = cvt_pk_bf16(gb[4], gb[5]); wg.w = cvt_pk_bf16(gb[6], gb[7]);
                    st_nt((u32x4*)(GA + off), wr_); st_nt((u32x4*)(GB + off), wg); }
        } else if (type == 3 || type == 5) {
            const int col = 128 * (type == 3 ? u.pn - 12 : u.pn - 16) + wc * 32 + 8 * fq;
#pragma unroll
            for (int ai = 0; ai < 2; ++ai)
#pragma unroll
                for (int m = 0; m < 4; ++m) { bf16_t* rowp = U + (size_t)(row0 + ai * HALF + m * 16) * 1024 + col;
                    const f32x4 a0 = acc[ai][0][m][0], a1 = acc[ai][0][m][1], b0 = acc[ai][1][m][0], b1 = acc[ai][1][m][1];
                    const f32x4 u0 = a0 * sigm4(b0), u1 = a1 * sigm4(b1);
                    u32x4 w; w.x = cvt_pk_bf16(u0[0], u0[1]); w.y = cvt_pk_bf16(u0[2], u0[3]); w.z = cvt_pk_bf16(u1[0], u1[1]); w.w = cvt_pk_bf16(u1[2], u1[3]);
                    st_nt((u32x4*)rowp, w); }
        } else if (type == 2) {
            const int col0 = (u.pn & 3) * 256 + wc * 32 + 8 * fq;
#pragma unroll
            for (int ai = 0; ai < 2; ++ai)
#pragma unroll
                for (int m = 0; m < 4; ++m) { bf16_t* rowp = LF + (size_t)(row0 + ai * HALF + m * 16) * 1024 + col0;
#pragma unroll
                    for (int bj = 0; bj < 2; ++bj) { const f32x4 z0 = acc[ai][bj][m][0], z1 = acc[ai][bj][m][1];
                        const f32x4 s0 = sigm4(z0), s1 = sigm4(z1); u32x4 w; w.x = pk_f16(s0[0], s0[1]); w.y = pk_f16(s0[2], s0[3]); w.z = pk_f16(s1[0], s1[1]); w.w = pk_f16(s1[2], s1[3]);
                        st_nt((u32x4*)(rowp + bj * HALF), w); } }
        } else if (type == 0) plain<1>(acc, Q, u, row0, wc, fq);
        else if (type == 4) plain<0>(acc, V, u, row0, wc, fq);
        else plain<1>(acc, GS, u, row0, wc, fq);
    }
    template <int MODE  > static __device__ __forceinline__ void plain(const f32x4 (&acc)[2][2][4][2], bf16_t* dst, const Unit& u, int row0, int wc, int fq) {
        const int col0 = (u.pn & 3) * 256 + wc * 32 + 8 * fq;
#pragma unroll
        for (int ai = 0; ai < 2; ++ai)
#pragma unroll
            for (int m = 0; m < 4; ++m) { bf16_t* rowp = dst + (size_t)(row0 + ai * HALF + m * 16) * 1024 + col0;
#pragma unroll
                for (int bj = 0; bj < 2; ++bj) { f32x4 v0 = acc[ai][bj][m][0], v1 = acc[ai][bj][m][1];
                    if (MODE == 1) { v0 = v0 * sigm4(v0); v1 = v1 * sigm4(v1); }
                    u32x4 w; w.x = cvt_pk_bf16(v0[0], v0[1]); w.y = cvt_pk_bf16(v0[2], v0[3]); w.z = cvt_pk_bf16(v1[0], v1[1]); w.w = cvt_pk_bf16(v1[2], v1[3]);
                    st_nt((u32x4*)(rowp + bj * HALF), w); } }
    }
};

struct EpiMerge {
    static constexpr bool PERM = true, AFTER_DRAIN = false, HAS_MID = true; static constexpr int AUX_A = 0;
    bf16_t* MG; const bf16_t *RT, *GB;
    __device__ __forceinline__ void mid(f32x4 (&acc)[2][2][4][2], const Unit& u, int wr, int wc, int fr, int fq) const {
        int row0 = u.pm * BM + wr * 64 + fr; asm volatile("" : "+v"(row0));
        const int col0 = u.pn * 256 + wc * 32 + 8 * fq;
#pragma unroll
        for (int ai = 0; ai < 2; ++ai)
#pragma unroll
            for (int m = 0; m < 4; ++m) { const size_t off = (size_t)(row0 + ai * HALF + m * 16) * 1024 + col0;
#pragma unroll
                for (int bj = 0; bj < 2; ++bj) { const u32x4 g = *(const u32x4*)(RT + off + bj * HALF); f32x4 v0 = acc[ai][bj][m][0], v1 = acc[ai][bj][m][1];
                    v0[0] *= bf_lo(g.x); v0[1] *= bf_hi(g.x); v0[2] *= bf_lo(g.y); v0[3] *= bf_hi(g.y); v1[0] *= bf_lo(g.z); v1[1] *= bf_hi(g.z); v1[2] *= bf_lo(g.w); v1[3] *= bf_hi(g.w);
                    acc[ai][bj][m][0] = v0; acc[ai][bj][m][1] = v1; }
                if (m == 3) asm volatile("" ::: "memory"); }
    }
    __device__ __forceinline__ void operator()(const f32x4 (&acc)[2][2][4][2], const Unit& u, int wr, int wc, int fr, int fq) const {
        const int row0 = u.pm * BM + wr * 64 + fr; const int col0 = u.pn * 256 + wc * 32 + 8 * fq;
#pragma unroll
        for (int ai = 0; ai < 2; ++ai) {
            u32x4 gq[4][2];
#pragma unroll
            for (int m = 0; m < 4; ++m)
#pragma unroll
                for (int bj = 0; bj < 2; ++bj) gq[m][bj] = *(const u32x4*)(GB + (size_t)(row0 + ai * HALF + m * 16) * 1024 + col0 + bj * HALF);
#pragma unroll
            for (int m = 0; m < 4; ++m) { const size_t off = (size_t)(row0 + ai * HALF + m * 16) * 1024 + col0;
#pragma unroll
                for (int bj = 0; bj < 2; ++bj) { const u32x4 g = gq[m][bj]; f32x4 v0 = acc[ai][bj][m][0], v1 = acc[ai][bj][m][1];
                    v0[0] *= bf_lo(g.x); v0[1] *= bf_hi(g.x); v0[2] *= bf_lo(g.y); v0[3] *= bf_hi(g.y); v1[0] *= bf_lo(g.z); v1[1] *= bf_hi(g.z); v1[2] *= bf_lo(g.w); v1[3] *= bf_hi(g.w);
                    u32x4 w; w.x = cvt_pk_bf16(v0[0], v0[1]); w.y = cvt_pk_bf16(v0[2], v0[3]); w.z = cvt_pk_bf16(v1[0], v1[1]); w.w = cvt_pk_bf16(v1[2], v1[3]);
                    *(u32x4*)(MG + off + bj * HALF) = w; } } }
    }
};

struct EpiX1 {
    static constexpr bool PERM = true, AFTER_DRAIN = false, HAS_MID = false; static constexpr int AUX_A = 0;
    const bf16_t* H; const float* RINV; const float* G1; bf16_t* XB; float* SS;
    __device__ __forceinline__ void operator()(const f32x4 (&acc)[2][2][4][2], const Unit& u, int wr, int wc, int fr, int fq) const {
        const int row0 = u.pm * BM + wr * 64 + fr, col0 = u.pn * BM + wc * 32 + 8 * fq;
        f32x4 gi[2][2];
#pragma unroll
        for (int bj = 0; bj < 2; ++bj)
#pragma unroll
            for (int n = 0; n < 2; ++n) { const f32x4 g = *(const f32x4*)(G1 + col0 + bj * HALF + n * 4);
                gi[bj][n] = (f32x4){__builtin_amdgcn_rcpf(g[0]), __builtin_amdgcn_rcpf(g[1]), __builtin_amdgcn_rcpf(g[2]), __builtin_amdgcn_rcpf(g[3])}; }
#pragma unroll
        for (int ai = 0; ai < 2; ++ai) {
            u32x4 xq[4][2]; float ri[4];
#pragma unroll
            for (int m = 0; m < 4; ++m) { ri[m] = RINV[row0 + ai * HALF + m * 16];
#pragma unroll
                for (int bj = 0; bj < 2; ++bj) xq[m][bj] = *(const u32x4*)(H + (size_t)(row0 + ai * HALF + m * 16) * 1024 + col0 + bj * HALF); }
#pragma unroll
            for (int m = 0; m < 4; ++m) { const int row = row0 + ai * HALF + m * 16; const size_t off = (size_t)row * 1024 + col0; float q = 0.f;
#pragma unroll
                for (int bj = 0; bj < 2; ++bj) { const u32x4 hb = xq[m][bj];
                    const f32x4 v0 = (f32x4){bf_lo(hb.x), bf_hi(hb.x), bf_lo(hb.y), bf_hi(hb.y)} * ri[m] * gi[bj][0] + acc[ai][bj][m][0];
                    const f32x4 v1 = (f32x4){bf_lo(hb.z), bf_hi(hb.z), bf_lo(hb.w), bf_hi(hb.w)} * ri[m] * gi[bj][1] + acc[ai][bj][m][1];
                    q += ((v0[0] * v0[0] + v0[1] * v0[1]) + (v0[2] * v0[2] + v0[3] * v0[3])) + ((v1[0] * v1[0] + v1[1] * v1[1]) + (v1[2] * v1[2] + v1[3] * v1[3]));
                    u32x4 w; w.x = cvt_pk_bf16(v0[0], v0[1]); w.y = cvt_pk_bf16(v0[2], v0[3]); w.z = cvt_pk_bf16(v1[0], v1[1]); w.w = cvt_pk_bf16(v1[2], v1[3]);
                    *(u32x4*)(XB + off + bj * HALF) = w; }
                q += __shfl_xor(q, 16); q += __shfl_xor(q, 32);
                if (fq == 0) SS[(size_t)row * 16 + u.pn * 4 + wc] = q; } }
    }
};
struct EpiZZ {
    static constexpr bool PERM = true, AFTER_DRAIN = false, HAS_MID = false; static constexpr int AUX_A = 0;
    bf16_t* ZZ; const float* SS;
    __device__ __forceinline__ void operator()(const f32x4 (&acc)[2][2][4][2], const Unit& u, int wr, int wc, int fr, int fq) const {
        const int row0 = u.pm * BM + wr * 64 + fr, col0 = u.pn * BM + wc * 32 + 8 * fq;
        float r2v[2][4];
        { f32x4 pq[2][4];
#pragma unroll
          for (int ai = 0; ai < 2; ++ai)
#pragma unroll
              for (int m = 0; m < 4; ++m) pq[ai][m] = *(const f32x4*)(SS + (size_t)(row0 + ai * HALF + m * 16) * 16 + 4 * fq);
#pragma unroll
          for (int ai = 0; ai < 2; ++ai)
#pragma unroll
              for (int m = 0; m < 4; ++m) { const f32x4 p = pq[ai][m]; float s = (p[0] + p[1]) + (p[2] + p[3]); s += __shfl_xor(s, 16); s += __shfl_xor(s, 32);
                  r2v[ai][m] = __builtin_amdgcn_rcpf(s * (1.0f / 1024.0f) + 1e-6f); } }
#pragma unroll
        for (int ai = 0; ai < 2; ++ai)
#pragma unroll
            for (int m = 0; m < 4; ++m) { const int row = row0 + ai * HALF + m * 16;
                const float r2 = r2v[ai][m];
                bf16_t* rowp = ZZ + (size_t)row * 4096 + col0;
#pragma unroll
                for (int bj = 0; bj < 2; ++bj) { f32x4 v0 = acc[ai][bj][m][0], v1 = acc[ai][bj][m][1];
#pragma unroll
                    for (int j = 0; j < 4; ++j) { const float a = fmaxf(v0[j], 0.f), b = fmaxf(v1[j], 0.f); v0[j] = a * a * r2; v1[j] = b * b * r2; }
                    u32x4 w; w.x = cvt_pk_bf16(v0[0], v0[1]); w.y = cvt_pk_bf16(v0[2], v0[3]); w.z = cvt_pk_bf16(v1[0], v1[1]); w.w = cvt_pk_bf16(v1[2], v1[3]);
                    st_nt((u32x4*)(rowp + bj * HALF), w); } }
    }
};
struct EpiX2 {
    static constexpr bool PERM = true, AFTER_DRAIN = false, HAS_MID = false; static constexpr int AUX_A = 0;
    const bf16_t* XB; float* OUT; const float* GF; float* SS2; unsigned* CNT;
    __device__ __forceinline__ void operator()(const f32x4 (&acc_)[2][2][4][2], const Unit& u, int wr, int wc, int fr, int fq) const {
        f32x4 (&acc)[2][2][4][2] = const_cast<f32x4 (&)[2][2][4][2]>(acc_);
        const int row0 = u.pm * BM + wr * 64 + fr, col0 = u.pn * BM + wc * 32 + 8 * fq;
#pragma unroll
        for (int ai = 0; ai < 2; ++ai) {
            u32x4 xq[4][2];
#pragma unroll
            for (int m = 0; m < 4; ++m)
#pragma unroll
                for (int bj = 0; bj < 2; ++bj) xq[m][bj] = *(const u32x4*)(XB + (size_t)(row0 + ai * HALF + m * 16) * 1024 + col0 + bj * HALF);
#pragma unroll
            for (int m = 0; m < 4; ++m) { const int row = row0 + ai * HALF + m * 16; float q = 0.f;
#pragma unroll
                for (int bj = 0; bj < 2; ++bj) { const u32x4 xb = xq[m][bj]; f32x4 v0 = acc[ai][bj][m][0], v1 = acc[ai][bj][m][1];
                    v0[0] += bf_lo(xb.x); v0[1] += bf_hi(xb.x); v0[2] += bf_lo(xb.y); v0[3] += bf_hi(xb.y); v1[0] += bf_lo(xb.z); v1[1] += bf_hi(xb.z); v1[2] += bf_lo(xb.w); v1[3] += bf_hi(xb.w);
                    acc[ai][bj][m][0] = v0; acc[ai][bj][m][1] = v1;
                    q += ((v0[0] * v0[0] + v0[1] * v0[1]) + (v0[2] * v0[2] + v0[3] * v0[3])) + ((v1[0] * v1[0] + v1[1] * v1[1]) + (v1[2] * v1[2] + v1[3] * v1[3])); }
                q += __shfl_xor(q, 16); q += __shfl_xor(q, 32);
                if (fq == 0) (void)__hip_atomic_fetch_add(SS2 + row, q, __ATOMIC_RELAXED, __HIP_MEMORY_SCOPE_AGENT); } }
        asm volatile("s_waitcnt vmcnt(0)" ::: "memory");
        unsigned* cnt = CNT + 64 * u.pm;
        if ((threadIdx.x & 63) == 0) (void)__hip_atomic_fetch_add(cnt, 1u, __ATOMIC_RELAXED, __HIP_MEMORY_SCOPE_AGENT);
        { unsigned sp = 0; while ((unsigned)__builtin_amdgcn_readfirstlane(__hip_atomic_load(cnt, __ATOMIC_RELAXED, __HIP_MEMORY_SCOPE_AGENT)) < 32u) { __builtin_amdgcn_s_sleep(2); if (++sp > (1u << 22)) break; } }
        __builtin_amdgcn_fence(__ATOMIC_ACQUIRE, "agent");
        f32x4 gv[2][2];
#pragma unroll
        for (int bj = 0; bj < 2; ++bj)
#pragma unroll
            for (int n = 0; n < 2; ++n) gv[bj][n] = *(const f32x4*)(GF + col0 + bj * HALF + n * 4);
        float sv[2][4];
#pragma unroll
        for (int ai = 0; ai < 2; ++ai)
#pragma unroll
            for (int m = 0; m < 4; ++m) sv[ai][m] = __hip_atomic_load(SS2 + row0 + ai * HALF + m * 16, __ATOMIC_RELAXED, __HIP_MEMORY_SCOPE_AGENT);
#pragma unroll
        for (int ai = 0; ai < 2; ++ai)
#pragma unroll
            for (int m = 0; m < 4; ++m) { const int row = row0 + ai * HALF + m * 16; float* rowp = OUT + (size_t)row * 1024 + col0;
                const float s = sv[ai][m]; const float rstd = 1.0f / sqrtf(s * (1.0f / 1024.0f) + 1e-6f);
#pragma unroll
                for (int bj = 0; bj < 2; ++bj)
#pragma unroll
                    for (int n = 0; n < 2; ++n) *(f32x4*)(rowp + bj * HALF + n * 4) = acc[ai][bj][m][n] * rstd * gv[bj][n]; }
    }
};


struct EpiDry {
    static constexpr bool PERM = true, AFTER_DRAIN = false, HAS_MID = false; static constexpr int AUX_A = 0;
    float* SINK;
    __device__ __forceinline__ void operator()(const f32x4 (&acc)[2][2][4][2], const Unit& u, int wr, int wc, int fr, int fq) const {
        f32x4 s = (f32x4){0.f, 0.f, 0.f, 0.f};
#pragma unroll
        for (int ai = 0; ai < 2; ++ai)
#pragma unroll
            for (int bj = 0; bj < 2; ++bj)
#pragma unroll
                for (int m = 0; m < 4; ++m)
#pragma unroll
                    for (int n = 0; n < 2; ++n) s += acc[ai][bj][m][n];
        if (s[0] + s[1] + s[2] + s[3] == 1.2345e33f) SINK[0] = s[0];
    }
};
template <class Epi, class Sched, bool ALIGN_EPI = false, bool SP2 = false>
__device__ __forceinline__ void gemm_phase(PG8_LAS unsigned char* lds, const Gemm g, const Sched& S, const Epi& E) {
    const int tid = threadIdx.x, wid = __builtin_amdgcn_readfirstlane(tid >> 6), lane = tid & 63, wr = wid >> 2, wc = wid & 3, fr = lane & 15, fq = lane >> 4;
    const int K = g.K, nt = K / BK, LD = g.ld ? g.ld : g.K, skt = g.split_kt ? g.split_kt : (1 << 30);
    unsigned voffA[2], voffB[2];
#pragma unroll
    for (int i = 0; i < 2; ++i) { int R, C; stage_rc(tid * 16 + i * 8192, R, C); const int Rb = Epi::PERM ? ((R & ~31) + perm32(R & 31)) : R;
        voffA[i] = (unsigned)(R * LD + C) * 2u; voffB[i] = (unsigned)(Rb * LD + C) * 2u; }
    const size_t kstep = (size_t)(BK * 2);
    const long adjA = g.splitA - (long)g.split_kt * (BK * 2), adjB = g.splitB - (long)g.split_kt * (BK * 2);
    const size_t hstep = (size_t)HALF * LD * 2;
    const size_t tstep = 2 * hstep;
    const unsigned ldsw = (unsigned)wid * 1024u;
    const int aoff = lds_byte(wr * 64 + fr, fq * 8), boff = lds_byte(wc * 32 + fr, fq * 8);
#define PG8_SA(b, h) (((b) * 2 + (h)) * HTB)
#define PG8_SB(b, h) ((4 + (b) * 2 + (h)) * HTB)
#define PG8_STAGE(bufoff, gbase, voff) do { _Pragma("unroll") for (int _i = 0; _i < 2; ++_i) \
        __builtin_amdgcn_global_load_lds((const unsigned*)((const char*)(gbase) + (voff)[_i]), (PG8_LAS unsigned*)(lds + (bufoff) + ldsw + _i * 8192), 16, 0, 0); } while (0)
#define PG8_LDA(dst, b, h) do { _Pragma("unroll") for (int m = 0; m < 4; ++m) _Pragma("unroll") for (int k = 0; k < 2; ++k) dst[m][k] = *(const PG8_LAS bf16x8*)(lds + PG8_SA(b, h) + aoff + m * 2048 + k * 1024); } while (0)
#define PG8_LDB(dst, b, h) do { _Pragma("unroll") for (int n = 0; n < 2; ++n) _Pragma("unroll") for (int k = 0; k < 2; ++k) dst[n][k] = *(const PG8_LAS bf16x8*)(lds + PG8_SB(b, h) + boff + n * 2048 + k * 1024); } while (0)
#define PG8_MMA(ai, bj, At, Bt) do { __builtin_amdgcn_s_setprio(1); _Pragma("unroll") for (int m = 0; m < 4; ++m) _Pragma("unroll") for (int n = 0; n < 2; ++n) _Pragma("unroll") for (int k = 0; k < 2; ++k) \
        acc[ai][bj][m][n] = __builtin_amdgcn_mfma_f32_16x16x32_bf16(Bt[n][k], At[m][k], acc[ai][bj][m][n], 0, 0, 0); __builtin_amdgcn_s_setprio(0); } while (0)
#define PG8_WAIT_V(n) asm volatile("s_waitcnt vmcnt(" #n ")" ::: "memory")
#define PG8_WAIT_L(n) asm volatile("s_waitcnt lgkmcnt(" #n ")" ::: "memory")
#define PG8_BAR __builtin_amdgcn_s_barrier()
#define PG8_SCHED __builtin_amdgcn_sched_barrier(0)
    Unit cur, nxt; int ui = 0;
    if (!S.next(0, cur)) return;
    f32x4 acc[2][2][4][2];
#pragma unroll
    for (int a = 0; a < 2; ++a)
#pragma unroll
        for (int b = 0; b < 2; ++b)
#pragma unroll
            for (int m = 0; m < 4; ++m)
#pragma unroll
                for (int n = 0; n < 2; ++n) acc[a][b][m][n] = (f32x4){0.f, 0.f, 0.f, 0.f};
    bf16x8 At[4][2], B0[2][2], B1[2][2];
    const char* cA = (const char*)g.A + (size_t)cur.pm * tstep; const char* cB = (const char*)g.Bt + (size_t)cur.pn * tstep;
    S.a_ready(cur);
    if constexpr (SP2) {
        PG8_STAGE(PG8_SB(0, 0), cB, voffB); PG8_STAGE(PG8_SB(0, 1), cB + hstep, voffB); PG8_STAGE(PG8_SA(0, 0), cA, voffA); PG8_STAGE(PG8_SA(0, 1), cA + hstep, voffA);
        if (wr == 1) PG8_BAR;
        PG8_WAIT_V(2); PG8_BAR;
        PG8_STAGE(PG8_SB(1, 0), cB + kstep, voffB); PG8_STAGE(PG8_SA(1, 0), cA + kstep, voffA); PG8_STAGE(PG8_SB(1, 1), cB + hstep + kstep, voffB);
        PG8_WAIT_V(6); PG8_BAR;
    } else {
        PG8_STAGE(PG8_SB(0, 0), cB, voffB); PG8_STAGE(PG8_SA(0, 0), cA, voffA); PG8_STAGE(PG8_SB(0, 1), cB + hstep, voffB); PG8_STAGE(PG8_SA(0, 1), cA + hstep, voffA);
        if (wr == 1) PG8_BAR;
        PG8_WAIT_V(4); PG8_BAR;
        PG8_STAGE(PG8_SB(1, 0), cB + kstep, voffB); PG8_STAGE(PG8_SA(1, 0), cA + kstep, voffA); PG8_STAGE(PG8_SB(1, 1), cB + hstep + kstep, voffB);
        PG8_WAIT_V(6); PG8_BAR;
    }
    for (;;) {
        const bool has_next = S.next(ui + 1, nxt);
        const char* nA = has_next ? (const char*)g.A + (size_t)nxt.pm * tstep : cA; const char* nB = has_next ? (const char*)g.Bt + (size_t)nxt.pn * tstep : cB;
        for (int t = 0; t < nt; t += 2) {
            const bool last = (t == nt - 2);
            const char* a1 = cA + (size_t)(t + 1) * kstep + (t + 1 >= skt ? adjA : 0);
            const char* a2 = last ? nA : cA + (size_t)(t + 2) * kstep + (t + 2 >= skt ? adjA : 0); const char* b2 = last ? nB : cB + (size_t)(t + 2) * kstep + (t + 2 >= skt ? adjB : 0);
            if constexpr (Epi::HAS_MID) { if (t == skt) E.mid(acc, cur, wr, wc, fr, fq); }
            const char* a3 = a2 + kstep; const char* b3 = b2 + kstep;
            if (last && has_next) S.a_ready(nxt);
            if constexpr (SP2) {
            PG8_LDB(B0, 0, 0); PG8_LDB(B1, 0, 1); PG8_SCHED; PG8_LDA(At, 0, 0); PG8_STAGE(PG8_SA(1, 1), a1 + hstep, voffA);
            PG8_WAIT_V(8); PG8_WAIT_L(0); PG8_BAR; PG8_MMA(0, 0, At, B0); PG8_MMA(0, 1, At, B1); PG8_BAR; PG8_SCHED;
            PG8_LDA(At, 0, 1); PG8_STAGE(PG8_SB(0, 0), b2, voffB); PG8_STAGE(PG8_SB(0, 1), b2 + hstep, voffB); PG8_STAGE(PG8_SA(0, 0), a2, voffA);
            PG8_WAIT_V(8); PG8_WAIT_L(0); PG8_BAR; PG8_MMA(1, 0, At, B0); PG8_MMA(1, 1, At, B1); PG8_BAR; PG8_SCHED;
            PG8_LDB(B0, 1, 0); PG8_LDB(B1, 1, 1); PG8_SCHED; PG8_LDA(At, 1, 0); PG8_STAGE(PG8_SA(0, 1), a2 + hstep, voffA);
            PG8_WAIT_V(8); PG8_WAIT_L(0); PG8_BAR; PG8_MMA(0, 0, At, B0); PG8_MMA(0, 1, At, B1); PG8_BAR; PG8_SCHED;
            PG8_LDA(At, 1, 1); PG8_STAGE(PG8_SB(1, 0), b3, voffB); PG8_STAGE(PG8_SB(1, 1), b3 + hstep, voffB); PG8_STAGE(PG8_SA(1, 0), a3, voffA);
            PG8_WAIT_V(8); PG8_WAIT_L(0); PG8_BAR; PG8_MMA(1, 0, At, B0); PG8_MMA(1, 1, At, B1); PG8_BAR; PG8_SCHED;
            } else {
            PG8_LDB(B0, 0, 0); PG8_SCHED; PG8_LDA(At, 0, 0); PG8_STAGE(PG8_SA(1, 1), a1 + hstep, voffA);
            PG8_WAIT_L(8); PG8_BAR; PG8_WAIT_L(0); PG8_MMA(0, 0, At, B0); PG8_BAR; PG8_SCHED;
            PG8_LDB(B1, 0, 1); PG8_STAGE(PG8_SB(0, 0), b2, voffB);
            PG8_BAR; PG8_WAIT_L(0); PG8_MMA(0, 1, At, B1); PG8_BAR;
            PG8_LDA(At, 0, 1); PG8_STAGE(PG8_SA(0, 0), a2, voffA);
            PG8_BAR; PG8_WAIT_L(0); PG8_MMA(1, 0, At, B0); PG8_BAR; PG8_SCHED;
            PG8_STAGE(PG8_SB(0, 1), b2 + hstep, voffB);
            PG8_WAIT_V(6); PG8_BAR; PG8_MMA(1, 1, At, B1); PG8_BAR;
            PG8_LDB(B0, 1, 0); PG8_SCHED; PG8_LDA(At, 1, 0); PG8_STAGE(PG8_SA(0, 1), a2 + hstep, voffA);
            PG8_WAIT_L(8); PG8_BAR; PG8_WAIT_L(0); PG8_MMA(0, 0, At, B0); PG8_BAR; PG8_SCHED;
            PG8_LDB(B1, 1, 1); PG8_STAGE(PG8_SB(1, 0), b3, voffB);
            PG8_BAR; PG8_WAIT_L(0); PG8_MMA(0, 1, At, B1); PG8_BAR;
            PG8_LDA(At, 1, 1); PG8_STAGE(PG8_SA(1, 0), a3, voffA);
            PG8_BAR; PG8_WAIT_L(0); PG8_MMA(1, 0, At, B0); PG8_BAR; PG8_SCHED;
            PG8_STAGE(PG8_SB(1, 1), b3 + hstep, voffB);
            PG8_WAIT_V(6); PG8_BAR; PG8_MMA(1, 1, At, B1); PG8_BAR;
            }
        }
        if constexpr (ALIGN_EPI) { if (wr == 0) PG8_BAR; }
        if constexpr (!Epi::AFTER_DRAIN) { E(acc, cur, wr, wc, fr, fq); S.done(cur); }
        if (!has_next) break;
#pragma unroll
        for (int a = 0; a < 2; ++a)
#pragma unroll
            for (int b = 0; b < 2; ++b)
#pragma unroll
                for (int m = 0; m < 4; ++m)
#pragma unroll
                    for (int n = 0; n < 2; ++n) acc[a][b][m][n] = (f32x4){0.f, 0.f, 0.f, 0.f};
        cur = nxt; cA = nA; cB = nB; ++ui;
        if constexpr (ALIGN_EPI) { if (wr == 1) PG8_BAR; }
    }
    PG8_WAIT_V(0);
    if constexpr (!ALIGN_EPI) { if (wr == 0) PG8_BAR; }
    PG8_BAR;
    if constexpr (Epi::AFTER_DRAIN) { E.fused(acc, cur, wr, wc, fr, fq, lds, wid, lane); S.done(cur); }
#undef PG8_SA
#undef PG8_SB
#undef PG8_STAGE
#undef PG8_LDA
#undef PG8_LDB
#undef PG8_MMA
#undef PG8_WAIT_V
#undef PG8_WAIT_L
#undef PG8_BAR
#undef PG8_SCHED
}
}

#ifndef MK_N_LAUNCHES
#define MK_N_LAUNCHES 1
#endif
namespace cg = cooperative_groups;
#define LAS __attribute__((address_space(3)))
#define DI __device__ __forceinline__
typedef unsigned short bf16;
typedef float f32x4 __attribute__((ext_vector_type(4)));
typedef float f32x2 __attribute__((ext_vector_type(2)));
typedef short bf16x8 __attribute__((ext_vector_type(8)));
typedef unsigned u32x4 __attribute__((ext_vector_type(4)));
typedef unsigned u32x2 __attribute__((ext_vector_type(2)));

constexpr int T = 32768, D = 1024, SEQ = 8192, DIN = 8192, FF = 4096;
constexpr float EPS = 1e-6f;
constexpr int NPHASES = 8;
constexpr int LDS_MISC = 131072;
constexpr int LDS_BYTES = 139264;

constexpr size_t MiB = 1u << 20;
constexpr size_t WS_WIN = 0;
constexpr size_t WS_L   = 0;
constexpr size_t WS_WA  = 16 * MiB;
constexpr size_t WS_WB  = 18 * MiB;
constexpr size_t WS_WO  = 20 * MiB;
constexpr size_t WS_WMI = 22 * MiB;
constexpr size_t WS_WMO = 30 * MiB;
constexpr size_t WS_SS  = 38 * MiB;
constexpr size_t WS_LB  = 40 * MiB;
constexpr size_t WS_DSEG = 40 * MiB + 65536;
constexpr size_t WS_CTL = 41 * MiB, CTL_CNT = 16384, CTL_SS2 = 65536, CTL_BYTES = 196608;
constexpr size_t WS_RINV = 42 * MiB;
constexpr size_t WS_END = 512 * MiB;
constexpr size_t SLOT = 64 * MiB;
constexpr size_t S_V = 1 * SLOT, S_U = 2 * SLOT, S_H = 3 * SLOT, S_LF = 4 * SLOT, S_GS = 5 * SLOT, S_GA = 6 * SLOT, S_GB = 7 * SLOT;
constexpr size_t S_X1B = S_V, S_OA = S_U, S_UB = S_H, S_MG = S_LF, S_ZZ = 2 * SLOT;

struct Args { const float* in[16]; float* out; unsigned char* ws; int ph_lo, ph_hi, sync_mode, pad; };

DI float wave_sum(float v) {
#pragma unroll
    for (int o = 1; o < 64; o <<= 1) v += __shfl_xor(v, o);
    return v;
}
DI unsigned f2bf(float f) { unsigned u = __builtin_bit_cast(unsigned, f); return (u + 0x7fffu + ((u >> 16) & 1u)) >> 16; }
typedef __bf16 bf16x2_t __attribute__((ext_vector_type(2)));
DI unsigned pk2(float lo, float hi) { f32x2 v = {lo, hi}; bf16x2_t b = __builtin_convertvector(v, bf16x2_t); return __builtin_bit_cast(unsigned, b); }
DI float bflo(unsigned w) { return __uint_as_float(w << 16); }
DI float bfhi(unsigned w) { return __uint_as_float(w & 0xffff0000u); }
DI float ex2(float x) { return __builtin_amdgcn_exp2f(x); }

DI void p0_transpose_item(const float* W, int K, int N, bf16* WT, int k0, int n0, int src_n0, const float* kscale, LAS float* scr, int lane) {
    float wv[32];
#pragma unroll
    for (int i = 0; i < 32; ++i) wv[i] = __builtin_nontemporal_load(W + (size_t)(k0 + 2 * i + (lane >> 5)) * N + src_n0 + (lane & 31));
#pragma unroll
    for (int i = 0; i < 32; ++i) { const int kk = 2 * i + (lane >> 5); float v = wv[i]; if (kscale) v *= kscale[k0 + kk]; scr[kk * 33 + (lane & 31)] = v; }
    asm volatile("s_waitcnt lgkmcnt(0)" ::: "memory");
    const int c = lane & 7;
#pragma unroll
    for (int j = 0; j < 4; ++j) { const int n = (lane >> 3) + 8 * j; const LAS float* s = scr + (8 * c) * 33 + n;
        u32x4 o; o.x = pk2(s[0 * 33], s[1 * 33]); o.y = pk2(s[2 * 33], s[3 * 33]); o.z = pk2(s[4 * 33], s[5 * 33]); o.w = pk2(s[6 * 33], s[7 * 33]);
        *(u32x4*)(WT + (size_t)(n0 + n) * K + k0 + 8 * c) = o; }
    asm volatile("s_waitcnt lgkmcnt(0)" ::: "memory");
}
DI void p0_matrix(const float* W, int K, int N, bf16* WT, const float* kscale, bool glu, LAS float* scr, int gw, int ngw, int lane) {
    const int nblk = N / 32, items = (K / 64) * nblk;
    for (int it = gw; it < items; it += ngw) { const int kb = it / nblk, nb = it % nblk; const int n0 = nb * 32; int src = n0;
        if (glu) {
            const int tile = n0 >> 8, r = n0 & 255;
            if (tile < 4) src = n0;
            else if (tile < 8) src = 3072 + (n0 - 1024);
            else if (tile < 12) src = 1024 + (n0 - 2048);
            else if (tile < 16) src = 4096 + (r >> 7) * 1024 + 128 * (tile - 12) + (r & 127);
            else if (tile < 20) src = 2048 + (n0 - 4096);
            else if (tile < 24) src = 4096 + (r >> 7) * 1024 + 128 * (tile - 20 + 4) + (r & 127);
            else src = 6144 + (r >> 7) * 1024 + 128 * (tile - 24) + (r & 127); }
        p0_transpose_item(W, K, N, WT, kb * 64, n0, src, kscale, scr, lane); }
}
DI void p0_prologue(const Args& a, LAS unsigned char* lds, int G, int tid, int lane, int wave) {
    LAS float* scr = (LAS float*)(lds + wave * 16384);
    const int gw = blockIdx.x * 8 + wave, ngw = G * 8;
    unsigned char* ws = a.ws;
    p0_matrix(a.in[2], D, DIN, (bf16*)(ws + WS_WIN), nullptr, true, scr, gw, ngw, lane);
    if (blockIdx.x == 0) { const float* lp = a.in[3]; float* LB = (float*)(ws + WS_LB);
        for (int c = tid; c < 1024; c += 512) LB[c] = 1.0f / (1.0f + __expf(lp[1024 + c] - lp[c])); }
    const float* x = a.in[0]; const float* g1 = a.in[1]; bf16* H = (bf16*)(ws + S_H);
    f32x4 gv[4];
#pragma unroll
    for (int j = 0; j < 4; ++j) gv[j] = *(const f32x4*)(g1 + 4 * lane + 256 * j);
    f32x4 nxv[4];
    if (gw < T) {
#pragma unroll
        for (int j = 0; j < 4; ++j) nxv[j] = __builtin_nontemporal_load((const f32x4*)(x + (size_t)gw * D) + lane + 64 * j); }
    for (int m = gw; m < T; m += ngw) { f32x4 v[4]; float s = 0.f;
#pragma unroll
        for (int j = 0; j < 4; ++j) v[j] = nxv[j];
        if (m + ngw < T) {
#pragma unroll
            for (int j = 0; j < 4; ++j) nxv[j] = __builtin_nontemporal_load((const f32x4*)(x + (size_t)(m + ngw) * D) + lane + 64 * j); }
#pragma unroll
        for (int j = 0; j < 4; ++j) s += (v[j].x * v[j].x + v[j].y * v[j].y) + (v[j].z * v[j].z + v[j].w * v[j].w);
        const float rms = sqrtf(wave_sum(s) * (1.0f / D) + EPS), rstd = 1.0f / rms; if (lane == 0) ((float*)(ws + WS_RINV))[m] = rms;
        u32x2* o = (u32x2*)(H + (size_t)m * D) + lane;
#pragma unroll
        for (int j = 0; j < 4; ++j) { u32x2 w; w.x = pk2(v[j].x * rstd * gv[j].x, v[j].y * rstd * gv[j].y); w.y = pk2(v[j].z * rstd * gv[j].z, v[j].w * rstd * gv[j].w); o[64 * j] = w; } }
}

DI void late_weights(const Args& a, LAS unsigned char* lds, int G, int lane, int wave) {
    LAS float* scr = (LAS float*)(lds + wave * 16384);
    const int gw = blockIdx.x * 8 + wave, ngw = G * 8;
    unsigned char* ws = a.ws;
    p0_matrix(a.in[5], D, D, (bf16*)(ws + WS_WA), nullptr, false, scr, gw, ngw, lane);
    p0_matrix(a.in[10], D, D, (bf16*)(ws + WS_WB), nullptr, false, scr, gw, ngw, lane);
    p0_matrix(a.in[11], D, D, (bf16*)(ws + WS_WO), nullptr, false, scr, gw, ngw, lane);
    p0_matrix(a.in[13], D, FF, (bf16*)(ws + WS_WMI), a.in[12], false, scr, gw, ngw, lane);
    p0_matrix(a.in[14], FF, D, (bf16*)(ws + WS_WMO), nullptr, false, scr, gw, ngw, lane);
}

constexpr int HQ_QT = 0, HQ_KT = 17408, HQ_KDT = 34816, HQ_VT = 53248, HQ_PP = 71680, HQ_ST = 80896, HQ_TOT = 115712, HQ_DV = 119808, HQ_SSQ = 120320;
constexpr int PA = 272, PB = 144;
DI bf16x8 ldfrag(const LAS unsigned char* base, int pitch, int row0, int k0, int lane) {
    return *(const LAS bf16x8*)(base + (row0 + (lane & 15)) * pitch + (k0 + 8 * (lane >> 4)) * 2);
}
#define MFMA16(a, b, c) __builtin_amdgcn_mfma_f32_16x16x32_bf16((a), (b), (c), 0, 0, 0)

template <bool PASS2>
DI void hgrn_unit(LAS unsigned char* lds, const Args& a, int unit, int tid, int lane, int w) {
    unsigned char* ws = a.ws;
    const bf16* Qb = (const bf16*)a.out;
    const bf16* Vb = (const bf16*)(ws + S_V); const bf16* LFb = (const bf16*)(ws + S_LF); const bf16* GSb = (const bf16*)(ws + S_GS); bf16* OA = (bf16*)(ws + S_OA);
    float* Lst = (float*)(ws + WS_L); float* DSEG = (float*)(ws + WS_DSEG); const float* HG = a.in[4];
    const int bh = unit >> 3, seg = unit & 7, b = bh >> 3, h = bh & 7;
    const size_t tok0 = (size_t)b * SEQ + (size_t)seg * 1024; const int cb = h * 128;
    const int fr = lane & 15, fq = lane >> 4;
    LAS float* TOT = (LAS float*)(lds + HQ_TOT); LAS float* DV = (LAS float*)(lds + HQ_DV); LAS float* SSQ = (LAS float*)(lds + HQ_SSQ);
    f32x4 S[8];
#pragma unroll
    for (int n = 0; n < 8; ++n) S[n] = (f32x4){0.f, 0.f, 0.f, 0.f};
    float segtot0 = 0.f, segtot1 = 0.f;
    const f32x2 lbv = *(const f32x2*)((const float*)(ws + WS_LB) + cb + 2 * lane); const f32x2 omlv = (f32x2){1.0f - lbv.x, 1.0f - lbv.y};
    f32x2 gh = (f32x2){1.f, 1.f};
    if (PASS2) {
        gh = *(const f32x2*)(HG + 2 * lane);
        float Lr[32], Dr[4];
#define HG_LLOAD(ii) do { const float* Li_ = Lst + (size_t)(bh * 8 + (ii)) * 16384 + (16 * w + 4 * fq) * 128 + fr; const float* Di_ = DSEG + (bh * 8 + (ii)) * 128 + 16 * w + 4 * fq; \
            _Pragma("unroll") for (int r = 0; r < 4; ++r) Dr[r] = Di_[r]; \
            _Pragma("unroll") for (int n = 0; n < 8; ++n) _Pragma("unroll") for (int r = 0; r < 4; ++r) Lr[n * 4 + r] = Li_[r * 128 + 16 * n]; } while (0)
        if (seg > 0) HG_LLOAD(0);
        for (int i = 0; i < seg; ++i) { float Lc[32], dd[4];
#pragma unroll
            for (int r = 0; r < 4; ++r) dd[r] = ex2(Dr[r]);
#pragma unroll
            for (int k = 0; k < 32; ++k) Lc[k] = Lr[k];
            if (i + 1 < seg) HG_LLOAD(i + 1);
#pragma unroll
            for (int n = 0; n < 8; ++n)
#pragma unroll
                for (int r = 0; r < 4; ++r) S[n][r] = S[n][r] * dd[r] + Lc[n * 4 + r]; }
#undef HG_LLOAD
#pragma unroll
        for (int n = 0; n < 8; ++n) { u32x2 pk; pk.x = pk2(S[n][0], S[n][1]); pk.y = pk2(S[n][2], S[n][3]); *(LAS u32x2*)(lds + HQ_ST + (16 * n + fr) * PA + (16 * w + 4 * fq) * 2) = pk; }
    }
    unsigned nlf[8], nv[8], nq[8], ngs[8];
#define HG_LOAD(cc) do { const size_t rb_ = tok0 + (size_t)(cc) * 64 + 8 * w; _Pragma("unroll") for (int i = 0; i < 8; ++i) { const size_t off = (rb_ + i) * D + cb + 2 * lane; \
            nlf[i] = *(const unsigned*)(LFb + off); nv[i] = *(const unsigned*)(Vb + off); if (PASS2) { nq[i] = *(const unsigned*)(Qb + off); ngs[i] = *(const unsigned*)(GSb + off); } } } while (0)
    HG_LOAD(0);
    for (int c = 0; c < 16; ++c) {
        unsigned vr[8], qr[8], gsc[8];
#pragma unroll
        for (int i = 0; i < 8; ++i) { vr[i] = nv[i]; if (PASS2) { qr[i] = nq[i]; gsc[i] = ngs[i]; } }
        f32x2 pl[8], kf[8]; f32x2 run = (f32x2){1.f, 1.f};
#pragma unroll
        for (int i = 0; i < 8; ++i) { const pg8::f16x2 hv = __builtin_bit_cast(pg8::f16x2, nlf[i]); const f32x2 s2 = (f32x2){(float)hv.x, (float)hv.y};
            run = run * (lbv + omlv * s2); pl[i] = run; kf[i] = omlv - omlv * s2; }
        *(LAS f32x2*)(TOT + w * 128 + 2 * lane) = run;
        __syncthreads();
        f32x2 pre = (f32x2){1.f, 1.f}, tot = (f32x2){1.f, 1.f};
#pragma unroll
        for (int ww = 0; ww < 8; ++ww) { const f32x2 t = *(const LAS f32x2*)(TOT + ww * 128 + 2 * lane); tot = tot * t; if (ww < w) pre = pre * t; }
        segtot0 += __builtin_amdgcn_logf(tot.x); segtot1 += __builtin_amdgcn_logf(tot.y);
        unsigned kd0[4], kd1[4];
#pragma unroll
        for (int i = 0; i < 8; i += 2) {
            f32x2 kd[2];
#pragma unroll
            for (int e = 0; e < 2; ++e) { const int ii = i + e; f32x2 E = pre * pl[ii]; E.x = fmaxf(E.x, 2.4e-35f); E.y = fmaxf(E.y, 2.4e-35f);
                const f32x2 inv = (f32x2){__builtin_amdgcn_rcpf(E.x), __builtin_amdgcn_rcpf(E.y)}; const f32x2 kt = kf[ii] * inv; kd[e] = kt * tot;
                if (PASS2) { const f32x2 q2 = (f32x2){bflo(qr[ii]), bfhi(qr[ii])} * E;
                    *(LAS unsigned*)(lds + HQ_QT + (8 * w + ii) * PA + 4 * lane) = pk2(q2.x, q2.y);
                    *(LAS unsigned*)(lds + HQ_KT + (8 * w + ii) * PA + 4 * lane) = pk2(kt.x, kt.y); } }
            kd0[i >> 1] = pk2(kd[0].x, kd[1].x); kd1[i >> 1] = pk2(kd[0].y, kd[1].y); }
        *(LAS u32x4*)(lds + HQ_KDT + (2 * lane) * PB + 16 * w) = (u32x4){kd0[0], kd0[1], kd0[2], kd0[3]};
        *(LAS u32x4*)(lds + HQ_KDT + (2 * lane + 1) * PB + 16 * w) = (u32x4){kd1[0], kd1[1], kd1[2], kd1[3]};
        { u32x4 v0, v1;
          v0.x = (vr[0] & 0xffffu) | (vr[1] << 16); v0.y = (vr[2] & 0xffffu) | (vr[3] << 16); v0.z = (vr[4] & 0xffffu) | (vr[5] << 16); v0.w = (vr[6] & 0xffffu) | (vr[7] << 16);
          v1.x = (vr[0] >> 16) | (vr[1] & 0xffff0000u); v1.y = (vr[2] >> 16) | (vr[3] & 0xffff0000u); v1.z = (vr[4] >> 16) | (vr[5] & 0xffff0000u); v1.w = (vr[6] >> 16) | (vr[7] & 0xffff0000u);
          *(LAS u32x4*)(lds + HQ_VT + (2 * lane) * PB + 16 * w) = v0; *(LAS u32x4*)(lds + HQ_VT + (2 * lane + 1) * PB + 16 * w) = v1; }
        if (w == 0) *(LAS f32x2*)(DV + 2 * lane) = tot;
        __syncthreads();
        if (c < 15) HG_LOAD(c + 1);
        if (PASS2) {
            const int tt = w & 3;
#pragma unroll
            for (int e = 0; e < 2; ++e) { const int st = 2 * (w >> 2) + e; f32x4 sc = (f32x4){0.f, 0.f, 0.f, 0.f};
                if (st <= tt) {
#pragma unroll
                    for (int ks = 0; ks < 4; ++ks) sc = MFMA16(ldfrag(lds + HQ_KT, PA, 16 * st, 32 * ks, lane), ldfrag(lds + HQ_QT, PA, 16 * tt, 32 * ks, lane), sc); }
                const int t = 16 * tt + fr, s0 = 16 * st + 4 * fq;
#pragma unroll
                for (int r = 0; r < 4; ++r) if (s0 + r > t) sc[r] = 0.f;
                u32x2 pk; pk.x = pk2(sc[0], sc[1]); pk.y = pk2(sc[2], sc[3]);
                *(LAS u32x2*)(lds + HQ_PP + t * PB + s0 * 2) = pk; }
            __syncthreads();
            const int mt = w & 3; f32x4 o[4];
#pragma unroll
            for (int j = 0; j < 4; ++j) o[j] = (f32x4){0.f, 0.f, 0.f, 0.f};
#pragma unroll
            for (int ks = 0; ks < 4; ++ks) { const bf16x8 bq = ldfrag(lds + HQ_QT, PA, 16 * mt, 32 * ks, lane);
#pragma unroll
                for (int j = 0; j < 4; ++j) o[j] = MFMA16(ldfrag(lds + HQ_ST, PA, 16 * (4 * (w >> 2) + j), 32 * ks, lane), bq, o[j]); }
#pragma unroll
            for (int ks = 0; ks < 2; ++ks) { const bf16x8 bp = ldfrag(lds + HQ_PP, PB, 16 * mt, 32 * ks, lane);
#pragma unroll
                for (int j = 0; j < 4; ++j) o[j] = MFMA16(ldfrag(lds + HQ_VT, PB, 16 * (4 * (w >> 2) + j), 32 * ks, lane), bp, o[j]); }
            float q = 0.f;
#pragma unroll
            for (int j = 0; j < 4; ++j) q += (o[j][0] * o[j][0] + o[j][1] * o[j][1]) + (o[j][2] * o[j][2] + o[j][3] * o[j][3]);
            q += __shfl_xor(q, 16); q += __shfl_xor(q, 32);
            if (fq == 0) SSQ[(16 * mt + fr) * 2 + (w >> 2)] = q;
            __syncthreads();
            { const f32x2 s2 = *(const LAS f32x2*)(SSQ + (16 * mt + fr) * 2); const float rstd = 1.0f / sqrtf((s2.x + s2.y) * (1.0f / 128.0f) + EPS);
#pragma unroll
              for (int j = 0; j < 4; ++j) { u32x2 pk; pk.x = pk2(o[j][0] * rstd, o[j][1] * rstd); pk.y = pk2(o[j][2] * rstd, o[j][3] * rstd);
                  *(LAS u32x2*)(lds + HQ_KT + (16 * mt + fr) * PA + (16 * (4 * (w >> 2) + j) + 4 * fq) * 2) = pk; } }
            __syncthreads();
#pragma unroll
            for (int i = 0; i < 8; ++i) { const unsigned ot = *(const LAS unsigned*)(lds + HQ_KT + (8 * w + i) * PA + 4 * lane);
                *(unsigned*)(OA + (tok0 + (size_t)c * 64 + 8 * w + i) * D + cb + 2 * lane) = pk2(bflo(ot) * gh.x * bflo(gsc[i]), bfhi(ot) * gh.y * bfhi(gsc[i])); }
        }
        { float dd[4];
#pragma unroll
          for (int r = 0; r < 4; ++r) dd[r] = DV[16 * w + 4 * fq + r];
          const bf16x8 a0 = ldfrag(lds + HQ_KDT, PB, 16 * w, 0, lane), a1 = ldfrag(lds + HQ_KDT, PB, 16 * w, 32, lane);
#pragma unroll
          for (int n = 0; n < 8; ++n) {
#pragma unroll
              for (int r = 0; r < 4; ++r) S[n][r] *= dd[r];
              S[n] = MFMA16(a0, ldfrag(lds + HQ_VT, PB, 16 * n, 0, lane), S[n]); S[n] = MFMA16(a1, ldfrag(lds + HQ_VT, PB, 16 * n, 32, lane), S[n]); }
          if (PASS2) {
#pragma unroll
              for (int n = 0; n < 8; ++n) { u32x2 pk; pk.x = pk2(S[n][0], S[n][1]); pk.y = pk2(S[n][2], S[n][3]); *(LAS u32x2*)(lds + HQ_ST + (16 * n + fr) * PA + (16 * w + 4 * fq) * 2) = pk; } }
        }
    }
    if (!PASS2) { float* Lu = Lst + (size_t)unit * 16384;
#pragma unroll
        for (int n = 0; n < 8; ++n)
#pragma unroll
            for (int r = 0; r < 4; ++r) Lu[(16 * w + 4 * fq + r) * 128 + 16 * n + fr] = S[n][r];
        if (w == 0) *(f32x2*)(DSEG + unit * 128 + 2 * lane) = (f32x2){segtot0, segtot1}; }
    __syncthreads();
#undef HG_LOAD
}

DI void conv_tile(LAS unsigned char* lds, const Args& a, int tile, int tid, int lane, int w) {
    unsigned char* ws = a.ws; const bf16* U = (const bf16*)(ws + S_U); bf16* UB = (bf16*)a.out + (size_t)T * D;
    const float *CW = a.in[6], *CBs = a.in[7], *LG = a.in[8], *LBt = a.in[9];
    const int t0 = tile * 128, pos0 = t0 & (SEQ - 1), c2 = 2 * tid;
    LAS float* RED = (LAS float*)lds;
    f32x2 wreg[31];
    const float* cwp = CW + c2; asm volatile("" : "+v"(cwp));
#pragma unroll
    for (int j = 0; j < 31; ++j) wreg[j] = *(const f32x2*)(cwp + j * 1024);
    const f32x2 bias = *(const f32x2*)(CBs + c2), lng = *(const f32x2*)(LG + c2), lnb = *(const f32x2*)(LBt + c2);
    f32x2 win[34];
#pragma unroll
    for (int i = 0; i < 30; ++i) { unsigned wv = 0u; if (pos0 + i - 30 >= 0) wv = *(const unsigned*)(U + (size_t)(t0 + i - 30) * D + c2); win[i] = (f32x2){bflo(wv), bfhi(wv)}; }
    unsigned nx[16];
#pragma unroll
    for (int i = 0; i < 16; ++i) nx[i] = *(const unsigned*)(U + (size_t)(t0 + i) * D + c2);
    for (int g4 = 0; g4 < 8; ++g4)
#pragma unroll
    for (int gg = 0; gg < 4; ++gg) { const int g = g4 * 4 + gg;
#pragma unroll
        for (int i = 0; i < 4; ++i) win[30 + i] = (f32x2){bflo(nx[gg * 4 + i]), bfhi(nx[gg * 4 + i])};
        if (g4 < 7) {
#pragma unroll
            for (int i = 0; i < 4; ++i) nx[gg * 4 + i] = *(const unsigned*)(U + (size_t)(t0 + (g + 4) * 4 + i) * D + c2); }
        f32x2 y[4]; float av[8];
#pragma unroll
        for (int o = 0; o < 4; ++o) { f32x2 acc = bias;
#pragma unroll
            for (int j = 0; j < 31; ++j) acc += wreg[j] * win[o + j];
            y[o] = acc; av[2 * o] = acc.x + acc.y; av[2 * o + 1] = acc.x * acc.x + acc.y * acc.y; }
        float dsum;
        { const bool h32 = (lane & 32) != 0, h16 = (lane & 16) != 0, h8 = (lane & 8) != 0; float b4[4], c2[2];
#pragma unroll
          for (int k = 0; k < 4; ++k) { const float snd = h32 ? av[k] : av[4 + k], kp = h32 ? av[4 + k] : av[k]; b4[k] = kp + __shfl_xor(snd, 32); }
#pragma unroll
          for (int k = 0; k < 2; ++k) { const float snd = h16 ? b4[k] : b4[2 + k], kp = h16 ? b4[2 + k] : b4[k]; c2[k] = kp + __shfl_xor(snd, 16); }
          { const float snd = h8 ? c2[0] : c2[1], kp = h8 ? c2[1] : c2[0]; dsum = kp + __shfl_xor(snd, 8); }
          dsum += __shfl_xor(dsum, 4); dsum += __shfl_xor(dsum, 2); dsum += __shfl_xor(dsum, 1); }
        LAS float* red = RED + (g & 1) * 64;
        if ((lane & 7) == 0) { const int idx = lane >> 3; red[(idx >> 1) * 16 + w * 2 + (idx & 1)] = dsum; }
        __syncthreads();
#pragma unroll
        for (int o = 0; o < 4; ++o) { const f32x4 p0 = *(const LAS f32x4*)(red + o * 16), p1 = *(const LAS f32x4*)(red + o * 16 + 4), p2 = *(const LAS f32x4*)(red + o * 16 + 8), p3 = *(const LAS f32x4*)(red + o * 16 + 12);
            const float sm = ((p0.x + p0.z) + (p1.x + p1.z)) + ((p2.x + p2.z) + (p3.x + p3.z)), qm = ((p0.y + p0.w) + (p1.y + p1.w)) + ((p2.y + p2.w) + (p3.y + p3.w));
            const float mean = sm * (1.0f / 1024.0f), var = fmaxf(qm * (1.0f / 1024.0f) - mean * mean, 0.f), rstd = 1.0f / sqrtf(var + EPS);
            const float y0 = (y[o].x - mean) * rstd * lng.x + lnb.x, y1 = (y[o].y - mean) * rstd * lng.y + lnb.y;
            *(unsigned*)(UB + (size_t)(t0 + g * 4 + o) * D + c2) = pk2(y0 * pg8::sigm(y0), y1 * pg8::sigm(y1)); }
#pragma unroll
        for (int i = 0; i < 30; ++i) win[i] = win[i + 4];
    }
    __syncthreads();
}

DI void final_norm(const Args& a, int G, int lane, int wave) {
    const float* gf = a.in[15]; float* out = a.out; const int gw = blockIdx.x * 8 + wave, ngw = G * 8;
    f32x4 gv[4];
#pragma unroll
    for (int j = 0; j < 4; ++j) gv[j] = *(const f32x4*)(gf + 4 * lane + 256 * j);
    for (int m = gw; m < T; m += ngw) { f32x4* xr = (f32x4*)(out + (size_t)m * D) + lane; f32x4 v[4]; float s = 0.f;
#pragma unroll
        for (int j = 0; j < 4; ++j) { v[j] = xr[64 * j]; s += (v[j].x * v[j].x + v[j].y * v[j].y) + (v[j].z * v[j].z + v[j].w * v[j].w); }
        const float rstd = 1.0f / sqrtf(wave_sum(s) * (1.0f / D) + EPS);
#pragma unroll
        for (int j = 0; j < 4; ++j) xr[64 * j] = v[j] * rstd * gv[j]; }
}

#define XB_TMO      128
#define XB_XCNT(j)  (256  + 64 * (j))
#define XB_XSUB(j)  (1280 + 64 * (j))
#define XB_XGEN(j)  (2304 + 64 * (j))
#define XB_TOP      3328
#define XB_TOPGEN   3392
#define XCD_BAR_WORDS 3456
#define XB_SPIN_CAP (1u << 18)

__device__ __forceinline__ unsigned xb_ld(unsigned* p)              { return __hip_atomic_load(p, __ATOMIC_RELAXED, __HIP_MEMORY_SCOPE_AGENT); }
__device__ __forceinline__ unsigned xb_add(unsigned* p, unsigned v) { return __hip_atomic_fetch_add(p, v, __ATOMIC_RELAXED, __HIP_MEMORY_SCOPE_AGENT); }
__device__ __forceinline__ unsigned xb_xcc_id() { return (unsigned)__builtin_amdgcn_s_getreg((3 << 11) | 20) & 0xFu; }
#define XB_SPIN(cond, bar) do { unsigned _sp = 0; while (cond) { __builtin_amdgcn_s_sleep(1); \
    if ((++_sp & 255u) == 0u) { if (xb_ld(&(bar)[XB_TMO])) break; if (_sp > XB_SPIN_CAP) { atomicAdd(&(bar)[XB_TMO], 1u); break; } } } } while (0)

struct XcdBarrier {
    unsigned* bar; unsigned x;
    volatile LAS unsigned* st;
};

__device__ __forceinline__ XcdBarrier xcd_barrier_post(unsigned* bar, volatile LAS unsigned* st) {
    XcdBarrier b; b.bar = bar; b.x = xb_xcc_id(); b.st = st;
    if (threadIdx.x == 0) (void)xb_add(&bar[XB_XCNT(b.x)], 1u);
    return b;
}
__device__ __forceinline__ void xcd_barrier_complete(unsigned* bar, unsigned x, unsigned& nloc, unsigned& nx) {
    const unsigned G = gridDim.x * gridDim.y * gridDim.z;
    unsigned sum, cnt, mine, sp = 0u;
    for (;;) {
        sum = 0u; cnt = 0u; mine = 0u;
#pragma unroll
        for (unsigned j = 0; j < 16; ++j) { const unsigned c = xb_ld(&bar[XB_XCNT(j)]); sum += c; cnt += (c > 0u) ? 1u : 0u; mine = (j == x) ? c : mine; }
        if (sum == G) break;
        __builtin_amdgcn_s_sleep(1);
        if ((++sp & 255u) == 0u) { if (xb_ld(&bar[XB_TMO])) break; if (sp > XB_SPIN_CAP) { atomicAdd(&bar[XB_TMO], 1u); break; } }
    }
    nloc = mine > 0u ? mine : 1u; nx = cnt > 0u ? cnt : 1u;
}

__device__ __forceinline__ void xcd_barrier(const XcdBarrier& b) {
    asm volatile("s_waitcnt vmcnt(0)" ::: "memory");
    __syncthreads();
    if (threadIdx.x == 0) {
        unsigned* bar = b.bar;
        __builtin_amdgcn_s_waitcnt(0);
        unsigned nloc = b.st[0], nx = b.st[1];
        if (nloc == 0u) { xcd_barrier_complete(bar, b.x, nloc, nx); b.st[0] = nloc; b.st[1] = nx; }
        const unsigned old = xb_add(&bar[XB_XSUB(b.x)], 1u);
        const unsigned gen = old / nloc;
        if (old + 1u == (gen + 1u) * nloc) {
            __builtin_amdgcn_fence(__ATOMIC_RELEASE, "agent");
            asm volatile("s_waitcnt vmcnt(0)" ::: "memory");
            const unsigned og = xb_add(&bar[XB_TOP], 1u);
            const unsigned tg = og / nx;
            if (og + 1u == (tg + 1u) * nx) xb_add(&bar[XB_TOPGEN], 1u);
            else XB_SPIN(xb_ld(&bar[XB_TOPGEN]) == tg, bar);
            __builtin_amdgcn_fence(__ATOMIC_ACQUIRE, "agent");
            xb_add(&bar[XB_XGEN(b.x)], 1u);
            asm volatile("s_waitcnt vmcnt(0)" ::: "memory");
        } else {
            XB_SPIN(xb_ld(&bar[XB_XGEN(b.x)]) == gen, bar);
            __builtin_amdgcn_fence(__ATOMIC_ACQUIRE, "agent");
            asm volatile("s_waitcnt vmcnt(0)" ::: "memory");
        }
    }
    __syncthreads();
}

__global__ void __launch_bounds__(512, 2) fwd_megakernel(Args args) {
    extern __shared__ __attribute__((aligned(16))) unsigned char lds_raw[];
    LAS unsigned char* lds = (LAS unsigned char*)lds_raw;
    const int tid = threadIdx.x, lane = tid & 63, wave = __builtin_amdgcn_readfirstlane(tid >> 6);
    const int G = gridDim.x; unsigned char* ws = args.ws;
    const int lo = args.ph_lo, hi = args.ph_hi;
#define IN(k) (lo <= (k) && (k) < hi)
#ifndef PROBE_REP
#define PROBE_REP -1
#endif
#ifndef PGA
#define PGA true
#endif
#ifndef WGM_P1
#define WGM_P1 2
#endif
#ifndef WGM_P6
#define WGM_P6 2
#endif
#ifndef PGS
#define PGS true
#endif
    if (args.sync_mode != 0) cg::this_grid().sync();
    volatile LAS unsigned* xst = (volatile LAS unsigned*)(lds + LDS_MISC);
    if (tid < 2) xst[tid] = 0u;
    __syncthreads();
    XcdBarrier xbar = xcd_barrier_post((unsigned*)(ws + WS_CTL), xst);
#define SEAM(k) do { if (IN(k) && IN((k) + 1)) { xcd_barrier(xbar); if (PROBE_REP == 99) { xcd_barrier(xbar); } } } while (0)
#define REPS(k) for (int rep_ = 0; rep_ < (PROBE_REP == (k) ? 2 : 1); ++rep_)
    bf16* Qb = (bf16*)args.out; bf16* Kb = (bf16*)args.out + (size_t)T * D;

    if (IN(0)) REPS(0) { p0_prologue(args, lds, G, tid, lane, wave); __syncthreads(); }
    SEAM(0);
    if (IN(1)) {
        pg8::Gemm g{(const bf16*)(ws + S_H), (const bf16*)(ws + WS_WIN), T, DIN, D}; pg8::StaticOrder S; S.init(T, DIN, G, (int)blockIdx.x, WGM_P1); S.rot = 4;
        pg8::EpiIn E{Qb, Kb, (bf16*)(ws + S_V), (bf16*)(ws + S_GS), (bf16*)(ws + S_U), (bf16*)(ws + S_GA), (bf16*)(ws + S_GB), (bf16*)(ws + S_LF), (const float*)(ws + WS_LB)};
        pg8::gemm_phase<pg8::EpiIn, pg8::StaticOrder, false, PGS>(lds, g, S, E);
    }
#if PROBE_REP == 1
    if (IN(1)) {
        pg8::Gemm g{(const bf16*)(ws + S_H), (const bf16*)(ws + WS_WIN), T, DIN, D}; pg8::StaticOrder S; S.init(T, DIN, G, (int)blockIdx.x, WGM_P1); S.rot = 4;
        pg8::EpiIn E{Qb, Kb, (bf16*)(ws + S_V), (bf16*)(ws + S_GS), (bf16*)(ws + S_U), (bf16*)(ws + S_GA), (bf16*)(ws + S_GB), (bf16*)(ws + S_LF), (const float*)(ws + WS_LB)};
        pg8::gemm_phase<pg8::EpiIn, pg8::StaticOrder, false, PGS>(lds, g, S, E);
    }
#endif
    SEAM(1);
    if (IN(2)) {
        const bool conv_first = ((blockIdx.x >> 3) & 1) != 0;
        if (!conv_first) { REPS(20) for (int u = blockIdx.x; u < 256; u += G) if ((u & 7) != 7) hgrn_unit<false>(lds, args, u, tid, lane, wave); }
        REPS(21) for (int t = blockIdx.x; t < T / 128; t += G) conv_tile(lds, args, t, tid, lane, wave);
        if (conv_first) { REPS(20) for (int u = blockIdx.x; u < 256; u += G) if ((u & 7) != 7) hgrn_unit<false>(lds, args, u, tid, lane, wave); }
    }
    SEAM(2);
    if (IN(3)) REPS(3) {
        for (int u = blockIdx.x; u < 256; u += G) hgrn_unit<true>(lds, args, u, tid, lane, wave);
        late_weights(args, lds, G, lane, wave); __syncthreads();
    }
    SEAM(3);
    if (IN(4)) {
        pg8::Gemm g{(const bf16*)(ws + S_OA), (const bf16*)(ws + WS_WA), T, D, 2 * D, D, 16, (long)((const char*)((const bf16*)args.out + (size_t)T * D) - (const char*)(ws + S_OA)), (long)(WS_WB - WS_WA)}; pg8::StaticOrder S; S.init(T, D, G, (int)blockIdx.x);
        pg8::EpiMerge E{(bf16*)(ws + S_MG), (const bf16*)(ws + S_GA), (const bf16*)(ws + S_GB)};
        pg8::gemm_phase<pg8::EpiMerge, pg8::StaticOrder, PGA, PGS>(lds, g, S, E);
    }
#if PROBE_REP == 4
    if (IN(4)) {
        pg8::Gemm g{(const bf16*)(ws + S_OA), (const bf16*)(ws + WS_WA), T, D, 2 * D, D, 16, (long)((const char*)((const bf16*)args.out + (size_t)T * D) - (const char*)(ws + S_OA)), (long)(WS_WB - WS_WA)}; pg8::StaticOrder S; S.init(T, D, G, (int)blockIdx.x);
        pg8::EpiMerge E{(bf16*)(ws + S_MG), (const bf16*)(ws + S_GA), (const bf16*)(ws + S_GB)};
        pg8::gemm_phase<pg8::EpiMerge, pg8::StaticOrder, PGA, PGS>(lds, g, S, E);
    }
#endif
    SEAM(4);
    if (IN(5)) {
        pg8::Gemm g{(const bf16*)(ws + S_MG), (const bf16*)(ws + WS_WO), T, D, D}; pg8::StaticOrder S; S.init(T, D, G, (int)blockIdx.x);
        pg8::EpiX1 E{(const bf16*)(ws + S_H), (const float*)(ws + WS_RINV), args.in[1], (bf16*)(ws + S_X1B), (float*)(ws + WS_SS)};
        pg8::gemm_phase<pg8::EpiX1, pg8::StaticOrder, PGA, PGS>(lds, g, S, E);
    }
#if PROBE_REP == 5
    if (IN(5)) {
        pg8::Gemm g{(const bf16*)(ws + S_MG), (const bf16*)(ws + WS_WO), T, D, D}; pg8::StaticOrder S; S.init(T, D, G, (int)blockIdx.x);
        pg8::EpiX1 E{(const bf16*)(ws + S_H), (const float*)(ws + WS_RINV), args.in[1], (bf16*)(ws + S_X1B), (float*)(ws + WS_SS)};
        pg8::gemm_phase<pg8::EpiX1, pg8::StaticOrder, PGA, PGS>(lds, g, S, E);
    }
#endif
    SEAM(5);
    if (IN(6)) {
        pg8::Gemm g{(const bf16*)(ws + S_X1B), (const bf16*)(ws + WS_WMI), T, FF, D}; pg8::StaticOrder S; S.init(T, FF, G, (int)blockIdx.x, WGM_P6);
        pg8::EpiZZ E{(bf16*)(ws + S_ZZ), (const float*)(ws + WS_SS)};
        pg8::gemm_phase<pg8::EpiZZ, pg8::StaticOrder, PGA, PGS>(lds, g, S, E);
    }
#if PROBE_REP == 6
    if (IN(6)) {
        pg8::Gemm g{(const bf16*)(ws + S_X1B), (const bf16*)(ws + WS_WMI), T, FF, D}; pg8::StaticOrder S; S.init(T, FF, G, (int)blockIdx.x, WGM_P6);
        pg8::EpiZZ E{(bf16*)(ws + S_ZZ), (const float*)(ws + WS_SS)};
        pg8::gemm_phase<pg8::EpiZZ, pg8::StaticOrder, PGA, PGS>(lds, g, S, E);
    }
#endif
    SEAM(6);
#if PROBE_REP == 7
    if (IN(7)) {
        pg8::Gemm g{(const bf16*)(ws + S_ZZ), (const bf16*)(ws + WS_WMO), T, D, FF}; pg8::StaticOrder S; S.init(T, D, G, (int)blockIdx.x);
        pg8::EpiDry E{(float*)(ws + WS_SS)};
        pg8::gemm_phase<pg8::EpiDry, pg8::StaticOrder, PGA, PGS>(lds, g, S, E);
    }
#endif
#if PROBE_REP == 61
    if (IN(6)) {
        pg8::Gemm g{(const bf16*)(ws + S_X1B), (const bf16*)(ws + WS_WMI), T, FF, D}; pg8::StaticOrder S; S.init(T, FF, G, (int)blockIdx.x, WGM_P6);
        pg8::EpiDry E{(float*)(ws + WS_SS)};
        pg8::gemm_phase<pg8::EpiDry, pg8::StaticOrder, PGA, PGS>(lds, g, S, E);
    }
#endif
    if (IN(7)) {
        pg8::Gemm g{(const bf16*)(ws + S_ZZ), (const bf16*)(ws + WS_WMO), T, D, FF}; pg8::StaticOrder S; S.init(T, D, G, (int)blockIdx.x);
        pg8::EpiX2 E{(const bf16*)(ws + S_X1B), args.out, args.in[15], (float*)(ws + WS_CTL + CTL_SS2), (unsigned*)(ws + WS_CTL + CTL_CNT)};
        pg8::gemm_phase<pg8::EpiX2, pg8::StaticOrder, PGA, PGS>(lds, g, S, E);
    }
#undef IN
#undef SEAM
}

extern "C" void kernel_launch(void* const* d_in, const int* in_sizes, int n_in, void* d_out, int out_size, void* d_ws, size_t ws_size, hipStream_t stream) {
    static int grid = 0;
    if (grid == 0) {
        int dev = 0, cus = 0, per_cu = 0;
        hipGetDevice(&dev); hipDeviceGetAttribute(&cus, hipDeviceAttributeMultiprocessorCount, dev);
        hipFuncSetAttribute((const void*)fwd_megakernel, hipFuncAttributeMaxDynamicSharedMemorySize, LDS_BYTES);
        hipOccupancyMaxActiveBlocksPerMultiprocessor(&per_cu, (const void*)fwd_megakernel, 512, LDS_BYTES);
        if (per_cu < 1) { fprintf(stderr, "kernel_launch: occupancy query says %d blocks per CU\n", per_cu); per_cu = 1; }
        grid = cus * per_cu; if (grid > 256) grid = 256;
        if (ws_size < WS_END) fprintf(stderr, "kernel_launch: workspace %zu < %zu needed\n", ws_size, (size_t)WS_END);
    }
    hipMemsetAsync((unsigned char*)d_ws + WS_CTL, 0, CTL_BYTES, stream);
    Args a{};
    for (int i = 0; i < 16; ++i) a.in[i] = (const float*)d_in[i];
    a.out = (float*)d_out; a.ws = (unsigned char*)d_ws;
#if MK_N_LAUNCHES == 1
    a.ph_lo = 0; a.ph_hi = NPHASES;
    void* kargs[] = {&a};
    hipError_t e = hipLaunchCooperativeKernel((const void*)fwd_megakernel, dim3(grid), dim3(512), kargs, LDS_BYTES, stream);
    if (e != hipSuccess) fprintf(stderr, "cooperative launch failed: %s (grid %d)\n", hipGetErrorString(e), grid);
#else
    for (int p = 0; p < NPHASES; ++p) { a.ph_lo = p; a.ph_hi = p + 1; hipLaunchKernelGGL(fwd_megakernel, dim3(grid), dim3(512), LDS_BYTES, stream, a); }
#endif
}
```

```cpp
#include <hip/hip_runtime.h>
#include <hip/hip_cooperative_groups.h>
#include <cstdio>
#include <cstdint>
namespace pg8 {
#define PG8_LAS __attribute__((address_space(3)))
typedef unsigned short bf16_t;
typedef short bf16x8 __attribute__((ext_vector_type(8)));
typedef float f32x4 __attribute__((ext_vector_type(4)));
typedef unsigned u32x4 __attribute__((ext_vector_type(4)));
constexpr int BM = 256, BK = 64, HALF = 128, HTB = HALF * BK * 2  , STAGE_BYTES = 8 * HTB, NXCD = 8, WGM = 2;

__host__ __device__ __forceinline__ int lds_byte(int r, int c) { const int st = (r >> 4) * 2 + (c >> 5), rr = r & 15, cc = c & 31, ob = rr * 64 + cc * 2; return st * 1024 + (ob ^ (((ob >> 9) & 1) << 5)); }
__host__ __device__ __forceinline__ void stage_rc(int b, int& R, int& C) { const int st = b / 1024, sb = b % 1024, swz = sb ^ (((sb >> 9) & 1) << 5); R = (st >> 1) * 16 + swz / 64; C = (st & 1) * 32 + (swz % 64) / 2; }
__host__ __device__ __forceinline__ int perm32(int rho) { const int n = rho >> 4, i = rho & 15; return 8 * (i >> 2) + 4 * n + (i & 3); }

struct Unit { int pm, pn; };
struct Gemm { const bf16_t* A; const bf16_t* Bt; int M, N, K; int ld, split_kt; long splitA, splitB; };

struct StaticOrder {
    int nM, nN, nwg, G, c, wgm, rot;
    __host__ __device__ void init(int M, int N, int G_, int c_, int wgm_ = WGM) { nM = M / BM; nN = N / BM; nwg = nM * nN; G = G_; c = c_; wgm = wgm_; rot = 0; }
    __host__ __device__ bool next(int i, Unit& u) const {
        const long L = (long)i * G + c; if (L >= nwg) return false;
        int wgid = (int)L; { const int q = nwg / NXCD, r = nwg % NXCD, xcd = wgid % NXCD, off = wgid / NXCD; wgid = (xcd < r ? xcd * (q + 1) : r * (q + 1) + (xcd - r) * q) + off; }
        const int nig = wgm * nN, gid = wgid / nig, fm = gid * wgm, gsz = (nM - fm) < wgm ? (nM - fm) : wgm;
        u.pm = fm + ((wgid % nig) % gsz); u.pn = (wgid % nig) / gsz; if (rot) u.pn = (u.pn & ~15) | ((u.pn + rot * gid) & 15); return true;
    }
    __device__ __forceinline__ void a_ready(const Unit&) const {}
    __device__ __forceinline__ void done(const Unit&) const {}
};

__device__ __forceinline__ unsigned cvt_pk_bf16(float lo, float hi) { unsigned r; asm volatile("v_cvt_pk_bf16_f32 %0, %1, %2" : "=v"(r) : "v"(lo), "v"(hi)); return r; }
typedef float f32x2 __attribute__((ext_vector_type(2)));

typedef unsigned u32x2 __attribute__((ext_vector_type(2)));
typedef _Float16 f16x2 __attribute__((ext_vector_type(2)));
__device__ __forceinline__ unsigned pk_f16(float a, float b) { f16x2 v; v.x = (_Float16)a; v.y = (_Float16)b; return __builtin_bit_cast(unsigned, v); }
__device__ __forceinline__ float bf_lo(unsigned w) { return __uint_as_float(w << 16); }
__device__ __forceinline__ float bf_hi(unsigned w) { return __uint_as_float(w & 0xffff0000u); }
template <class V> __device__ __forceinline__ void st_nt(V* p, V v) { __builtin_nontemporal_store(v, p); }
__device__ __forceinline__ float sigm(float z) { return __builtin_amdgcn_rcpf(1.0f + __builtin_amdgcn_exp2f(-1.4426950409f * z)); }
__device__ __forceinline__ f32x2 exp2n2(f32x2 z) { const f32x2 t = z * (-1.4426950409f); f32x2 e; e.x = __builtin_amdgcn_exp2f(t.x); e.y = __builtin_amdgcn_exp2f(t.y); return e; }
__device__ __forceinline__ f32x2 rcp2(f32x2 d) { f32x2 r; r.x = __builtin_amdgcn_rcpf(d.x); r.y = __builtin_amdgcn_rcpf(d.y); return r; }
__device__ __forceinline__ f32x2 sigm2(f32x2 z) { return rcp2(exp2n2(z) + 1.0f); }
__device__ __forceinline__ f32x4 sigm4(f32x4 z) { const f32x2 lo = sigm2(__builtin_shufflevector(z, z, 0, 1)), hi = sigm2(__builtin_shufflevector(z, z, 2, 3)); return (f32x4){lo.x, lo.y, hi.x, hi.y}; }

struct EpiIn {
    static constexpr bool PERM = true, AFTER_DRAIN = false, HAS_MID = false; static constexpr int AUX_A = 0;
    bf16_t *Q, *KK, *V, *GS, *U, *GA, *GB; bf16_t* LF; const float* LB;
    __device__ __forceinline__ void operator()(const f32x4 (&acc)[2][2][4][2], const Unit& u, int wr, int wc, int fr, int fq) const {
        const int row0 = u.pm * BM + wr * 64 + fr; const int type = u.pn >> 2;
        if (type >= 6) {
            const int col = 128 * (u.pn - 24) + wc * 32 + 8 * fq;
#pragma unroll
            for (int ai = 0; ai < 2; ++ai)
#pragma unroll
                for (int m = 0; m < 4; ++m) { const size_t off = (size_t)(row0 + ai * HALF + m * 16) * 1024 + col; float rr[8], gb[8];
#pragma unroll
                    for (int n = 0; n < 2; ++n)
#pragma unroll
                        for (int j = 0; j < 4; j += 2) { const f32x4 za = acc[ai][0][m][n], zb = acc[ai][1][m][n];
                            const f32x2 da = exp2n2((f32x2){za[j], za[j + 1]}) + 1.0f, db = exp2n2((f32x2){zb[j], zb[j + 1]}) + 1.0f;
                            const f32x2 r2 = db * rcp2(da), g2 = rcp2(db);
                            rr[4 * n + j] = r2.x; rr[4 * n + j + 1] = r2.y; gb[4 * n + j] = g2.x; gb[4 * n + j + 1] = g2.y; }
                    u32x4 wr_, wg; wr_.x = cvt_pk_bf16(rr[0], rr[1]); wr_.y = cvt_pk_bf16(rr[2], rr[3]); wr_.z = cvt_pk_bf16(rr[4], rr[5]); wr_.w = cvt_pk_bf16(rr[6], rr[7]);
                    wg.x = cvt_pk_bf16(gb[0], gb[1]); wg.y = cvt_pk_bf16(gb[2], gb[3]); wg.z = cvt_pk_bf16(gb[4], gb[5]); wg.w = cvt_pk_bf16(gb[6], gb[7]);
                    st_nt((u32x4*)(GA + off), wr_); st_nt((u32x4*)(GB + off), wg); }
        } else if (type == 3 || type == 5) {
            const int col = 128 * (type == 3 ? u.pn - 12 : u.pn - 16) + wc * 32 + 8 * fq;
#pragma unroll
            for (int ai = 0; ai < 2; ++ai)
#pragma unroll
                for (int m = 0; m < 4; ++m) { bf16_t* rowp = U + (size_t)(row0 + ai * HALF + m * 16) * 1024 + col;
                    const f32x4 a0 = acc[ai][0][m][0], a1 = acc[ai][0][m][1], b0 = acc[ai][1][m][0], b1 = acc[ai][1][m][1];
                    const f32x4 u0 = a0 * sigm4(b0), u1 = a1 * sigm4(b1);
                    u32x4 w; w.x = cvt_pk_bf16(u0[0], u0[1]); w.y = cvt_pk_bf16(u0[2], u0[3]); w.z = cvt_pk_bf16(u1[0], u1[1]); w.w = cvt_pk_bf16(u1[2], u1[3]);
                    st_nt((u32x4*)rowp, w); }
        } else if (type == 2) {
            const int col0 = (u.pn & 3) * 256 + wc * 32 + 8 * fq;
#pragma unroll
            for (int ai = 0; ai < 2; ++ai)
#pragma unroll
                for (int m = 0; m < 4; ++m) { bf16_t* rowp = LF + (size_t)(row0 + ai * HALF + m * 16) * 1024 + col0;
#pragma unroll
                    for (int bj = 0; bj < 2; ++bj) { const f32x4 z0 = acc[ai][bj][m][0], z1 = acc[ai][bj][m][1];
                        const f32x4 s0 = sigm4(z0), s1 = sigm4(z1); u32x4 w; w.x = pk_f16(s0[0], s0[1]); w.y = pk_f16(s0[2], s0[3]); w.z = pk_f16(s1[0], s1[1]); w.w = pk_f16(s1[2], s1[3]);
                        st_nt((u32x4*)(rowp + bj * HALF), w); } }
        } else if (type == 0) plain<1>(acc, Q, u, row0, wc, fq);
        else if (type == 4) plain<0>(acc, V, u, row0, wc, fq);
        else plain<1>(acc, GS, u, row0, wc, fq);
    }
    template <int MODE  > static __device__ __forceinline__ void plain(const f32x4 (&acc)[2][2][4][2], bf16_t* dst, const Unit& u, int row0, int wc, int fq) {
        const int col0 = (u.pn & 3) * 256 + wc * 32 + 8 * fq;
#pragma unroll
        for (int ai = 0; ai < 2; ++ai)
#pragma unroll
            for (int m = 0; m < 4; ++m) { bf16_t* rowp = dst + (size_t)(row0 + ai * HALF + m * 16) * 1024 + col0;
#pragma unroll
                for (int bj = 0; bj < 2; ++bj) { f32x4 v0 = acc[ai][bj][m][0], v1 = acc[ai][bj][m][1];
                    if (MODE == 1) { v0 = v0 * sigm4(v0); v1 = v1 * sigm4(v1); }
                    u32x4 w; w.x = cvt_pk_bf16(v0[0], v0[1]); w.y = cvt_pk_bf16(v0[2], v0[3]); w.z = cvt_pk_bf16(v1[0], v1[1]); w.w = cvt_pk_bf16(v1[2], v1[3]);
                    st_nt((u32x4*)(rowp + bj * HALF), w); } }
    }
};

struct EpiMerge {
    static constexpr bool PERM = true, AFTER_DRAIN = false, HAS_MID = true; static constexpr int AUX_A = 0;
    bf16_t* MG; const bf16_t *RT, *GB;
    __device__ __forceinline__ void mid(f32x4 (&acc)[2][2][4][2], const Unit& u, int wr, int wc, int fr, int fq) const {
        int row0 = u.pm * BM + wr * 64 + fr; asm volatile("" : "+v"(row0));
        const int col0 = u.pn * 256 + wc * 32 + 8 * fq;
#pragma unroll
        for (int ai = 0; ai < 2; ++ai)
#pragma unroll
            for (int m = 0; m < 4; ++m) { const size_t off = (size_t)(row0 + ai * HALF + m * 16) * 1024 + col0;
#pragma unroll
                for (int bj = 0; bj < 2; ++bj) { const u32x4 g = *(const u32x4*)(RT + off + bj * HALF); f32x4 v0 = acc[ai][bj][m][0], v1 = acc[ai][bj][m][1];
                    v0[0] *= bf_lo(g.x); v0[1] *= bf_hi(g.x); v0[2] *= bf_lo(g.y); v0[3] *= bf_hi(g.y); v1[0] *= bf_lo(g.z); v1[1] *= bf_hi(g.z); v1[2] *= bf_lo(g.w); v1[3] *= bf_hi(g.w);
                    acc[ai][bj][m][0] = v0; acc[ai][bj][m][1] = v1; }
                if (m == 3) asm volatile("" ::: "memory"); }
    }
    __device__ __forceinline__ void operator()(const f32x4 (&acc)[2][2][4][2], const Unit& u, int wr, int wc, int fr, int fq) const {
        const int row0 = u.pm * BM + wr * 64 + fr; const int col0 = u.pn * 256 + wc * 32 + 8 * fq;
#pragma unroll
        for (int ai = 0; ai < 2; ++ai) {
            u32x4 gq[4][2];
#pragma unroll
            for (int m = 0; m < 4; ++m)
#pragma unroll
                for (int bj = 0; bj < 2; ++bj) gq[m][bj] = *(const u32x4*)(GB + (size_t)(row0 + ai * HALF + m * 16) * 1024 + col0 + bj * HALF);
#pragma unroll
            for (int m = 0; m < 4; ++m) { const size_t off = (size_t)(row0 + ai * HALF + m * 16) * 1024 + col0;
#pragma unroll
                for (int bj = 0; bj < 2; ++bj) { const u32x4 g = gq[m][bj]; f32x4 v0 = acc[ai][bj][m][0], v1 = acc[ai][bj][m][1];
                    v0[0] *= bf_lo(g.x); v0[1] *= bf_hi(g.x); v0[2] *= bf_lo(g.y); v0[3] *= bf_hi(g.y); v1[0] *= bf_lo(g.z); v1[1] *= bf_hi(g.z); v1[2] *= bf_lo(g.w); v1[3] *= bf_hi(g.w);
                    u32x4 w; w.x = cvt_pk_bf16(v0[0], v0[1]); w.y = cvt_pk_bf16(v0[2], v0[3]); w.z = cvt_pk_bf16(v1[0], v1[1]); w.w = cvt_pk_bf16(v1[2], v1[3]);
                    *(u32x4*)(MG + off + bj * HALF) = w; } } }
    }
};

struct EpiX1 {
    static constexpr bool PERM = true, AFTER_DRAIN = false, HAS_MID = false; static constexpr int AUX_A = 0;
    const bf16_t* H; const float* RINV; const float* G1; bf16_t* XB; float* SS;
    __device__ __forceinline__ void operator()(const f32x4 (&acc)[2][2][4][2], const Unit& u, int wr, int wc, int fr, int fq) const {
        const int row0 = u.pm * BM + wr * 64 + fr, col0 = u.pn * BM + wc * 32 + 8 * fq;
        f32x4 gi[2][2];
#pragma unroll
        for (int bj = 0; bj < 2; ++bj)
#pragma unroll
            for (int n = 0; n < 2; ++n) { const f32x4 g = *(const f32x4*)(G1 + col0 + bj * HALF + n * 4);
                gi[bj][n] = (f32x4){__builtin_amdgcn_rcpf(g[0]), __builtin_amdgcn_rcpf(g[1]), __builtin_amdgcn_rcpf(g[2]), __builtin_amdgcn_rcpf(g[3])}; }
#pragma unroll
        for (int ai = 0; ai < 2; ++ai) {
            u32x4 xq[4][2]; float ri[4];
#pragma unroll
            for (int m = 0; m < 4; ++m) { ri[m] = RINV[row0 + ai * HALF + m * 16];
#pragma unroll
                for (int bj = 0; bj < 2; ++bj) xq[m][bj] = *(const u32x4*)(H + (size_t)(row0 + ai * HALF + m * 16) * 1024 + col0 + bj * HALF); }
#pragma unroll
            for (int m = 0; m < 4; ++m) { const int row = row0 + ai * HALF + m * 16; const size_t off = (size_t)row * 1024 + col0; float q = 0.f;
#pragma unroll
                for (int bj = 0; bj < 2; ++bj) { const u32x4 hb = xq[m][bj];
                    const f32x4 v0 = (f32x4){bf_lo(hb.x), bf_hi(hb.x), bf_lo(hb.y), bf_hi(hb.y)} * ri[m] * gi[bj][0] + acc[ai][bj][m][0];
                    const f32x4 v1 = (f32x4){bf_lo(hb.z), bf_hi(hb.z), bf_lo(hb.w), bf_hi(hb.w)} * ri[m] * gi[bj][1] + acc[ai][bj][m][1];
                    q += ((v0[0] * v0[0] + v0[1] * v0[1]) + (v0[2] * v0[2] + v0[3] * v0[3])) + ((v1[0] * v1[0] + v1[1] * v1[1]) + (v1[2] * v1[2] + v1[3] * v1[3]));
                    u32x4 w; w.x = cvt_pk_bf16(v0[0], v0[1]); w.y = cvt_pk_bf16(v0[2], v0[3]); w.z = cvt_pk_bf16(v1[0], v1[1]); w.w = cvt_pk_bf16(v1[2], v1[3]);
                    *(u32x4*)(XB + off + bj * HALF) = w; }
                q += __shfl_xor(q, 16); q += __shfl_xor(q, 32);
                if (fq == 0) SS[(size_t)row * 16 + u.pn * 4 + wc] = q; } }
    }
};
struct EpiZZ {
    static constexpr bool PERM = true, AFTER_DRAIN = false, HAS_MID = false; static constexpr int AUX_A = 0;
    bf16_t* ZZ; const float* SS;
    __device__ __forceinline__ void operator()(const f32x4 (&acc)[2][2][4][2], const Unit& u, int wr, int wc, int fr, int fq) const {
        const int row0 = u.pm * BM + wr * 64 + fr, col0 = u.pn * BM + wc * 32 + 8 * fq;
        float r2v[2][4];
        { f32x4 pq[2][4];
#pragma unroll
          for (int ai = 0; ai < 2; ++ai)
#pragma unroll
              for (int m = 0; m < 4; ++m) pq[ai][m] = *(const f32x4*)(SS + (size_t)(row0 + ai * HALF + m * 16) * 16 + 4 * fq);
#pragma unroll
          for (int ai = 0; ai < 2; ++ai)
#pragma unroll
              for (int m = 0; m < 4; ++m) { const f32x4 p = pq[ai][m]; float s = (p[0] + p[1]) + (p[2] + p[3]); s += __shfl_xor(s, 16); s += __shfl_xor(s, 32);
                  r2v[ai][m] = __builtin_amdgcn_rcpf(s * (1.0f / 1024.0f) + 1e-6f); } }
#pragma unroll
        for (int ai = 0; ai < 2; ++ai)
#pragma unroll
            for (int m = 0; m < 4; ++m) { const int row = row0 + ai * HALF + m * 16;
                const float r2 = r2v[ai][m];
                bf16_t* rowp = ZZ + (size_t)row * 4096 + col0;
#pragma unroll
                for (int bj = 0; bj < 2; ++bj) { f32x4 v0 = acc[ai][bj][m][0], v1 = acc[ai][bj][m][1];
#pragma unroll
                    for (int j = 0; j < 4; ++j) { const float a = fmaxf(v0[j], 0.f), b = fmaxf(v1[j], 0.f); v0[j] = a * a * r2; v1[j] = b * b * r2; }
                    u32x4 w; w.x = cvt_pk_bf16(v0[0], v0[1]); w.y = cvt_pk_bf16(v0[2], v0[3]); w.z = cvt_pk_bf16(v1[0], v1[1]); w.w = cvt_pk_bf16(v1[2], v1[3]);
                    st_nt((u32x4*)(rowp + bj * HALF), w); } }
    }
};
struct EpiX2 {
    static constexpr bool PERM = false, AFTER_DRAIN = false, HAS_MID = false; static constexpr int AUX_A = 0;
    const bf16_t* XB; float* OUT; const float* GF; float* SS2; unsigned* CNT;
    __device__ __forceinline__ void operator()(const f32x4 (&acc_)[2][2][4][2], const Unit& u, int wr, int wc, int fr, int fq) const {
        f32x4 (&acc)[2][2][4][2] = const_cast<f32x4 (&)[2][2][4][2]>(acc_);
        const int row0 = u.pm * BM + wr * 64 + fr, col0 = u.pn * BM + wc * 32 + 4 * fq;
#pragma unroll
        for (int ai = 0; ai < 2; ++ai) {
            u32x2 xq[4][2][2];
#pragma unroll
            for (int m = 0; m < 4; ++m)
#pragma unroll
                for (int bj = 0; bj < 2; ++bj)
#pragma unroll
                    for (int n = 0; n < 2; ++n) xq[m][bj][n] = *(const u32x2*)(XB + (size_t)(row0 + ai * HALF + m * 16) * 1024 + col0 + bj * HALF + n * 16);
#pragma unroll
            for (int m = 0; m < 4; ++m) { const int row = row0 + ai * HALF + m * 16; float q = 0.f;
#pragma unroll
                for (int bj = 0; bj < 2; ++bj)
#pragma unroll
                    for (int n = 0; n < 2; ++n) { const u32x2 xb = xq[m][bj][n]; f32x4 v = acc[ai][bj][m][n];
                        v[0] += bf_lo(xb.x); v[1] += bf_hi(xb.x); v[2] += bf_lo(xb.y); v[3] += bf_hi(xb.y); acc[ai][bj][m][n] = v;
                        q += (v[0] * v[0] + v[1] * v[1]) + (v[2] * v[2] + v[3] * v[3]); }
                q += __shfl_xor(q, 16); q += __shfl_xor(q, 32);
                if (fq == 0) (void)__hip_atomic_fetch_add(SS2 + row, q, __ATOMIC_RELAXED, __HIP_MEMORY_SCOPE_AGENT); } }
        asm volatile("s_waitcnt vmcnt(0)" ::: "memory");
        unsigned* cnt = CNT + 64 * u.pm;
        if ((threadIdx.x & 63) == 0) (void)__hip_atomic_fetch_add(cnt, 1u, __ATOMIC_RELAXED, __HIP_MEMORY_SCOPE_AGENT);
        { unsigned sp = 0; while ((unsigned)__builtin_amdgcn_readfirstlane(__hip_atomic_load(cnt, __ATOMIC_RELAXED, __HIP_MEMORY_SCOPE_AGENT)) < 32u) { __builtin_amdgcn_s_sleep(2); if (++sp > (1u << 22)) break; } }
        __builtin_amdgcn_fence(__ATOMIC_ACQUIRE, "agent");
        f32x4 gv[2][2];
#pragma unroll
        for (int bj = 0; bj < 2; ++bj)
#pragma unroll
            for (int n = 0; n < 2; ++n) gv[bj][n] = *(const f32x4*)(GF + col0 + bj * HALF + n * 16);
        float sv[2][4];
#pragma unroll
        for (int ai = 0; ai < 2; ++ai)
#pragma unroll
            for (int m = 0; m < 4; ++m) sv[ai][m] = __hip_atomic_load(SS2 + row0 + ai * HALF + m * 16, __ATOMIC_RELAXED, __HIP_MEMORY_SCOPE_AGENT);
#pragma unroll
        for (int ai = 0; ai < 2; ++ai)
#pragma unroll
            for (int m = 0; m < 4; ++m) { const int row = row0 + ai * HALF + m * 16; float* rowp = OUT + (size_t)row * 1024 + col0;
                const float s = sv[ai][m]; const float rstd = 1.0f / sqrtf(s * (1.0f / 1024.0f) + 1e-6f);
#pragma unroll
                for (int bj = 0; bj < 2; ++bj)
#pragma unroll
                    for (int n = 0; n < 2; ++n) st_nt((f32x4*)(rowp + bj * HALF + n * 16), acc[ai][bj][m][n] * rstd * gv[bj][n]); }
    }
};

struct EpiDry {
    static constexpr bool PERM = true, AFTER_DRAIN = false, HAS_MID = false; static constexpr int AUX_A = 0;
    float* SINK;
    __device__ __forceinline__ void operator()(const f32x4 (&acc)[2][2][4][2], const Unit& u, int wr, int wc, int fr, int fq) const {
        f32x4 s = (f32x4){0.f, 0.f, 0.f, 0.f};
#pragma unroll
        for (int ai = 0; ai < 2; ++ai)
#pragma unroll
            for (int bj = 0; bj < 2; ++bj)
#pragma unroll
                for (int m = 0; m < 4; ++m)
#pragma unroll
                    for (int n = 0; n < 2; ++n) s += acc[ai][bj][m][n];
        if (s[0] + s[1] + s[2] + s[3] == 1.2345e33f) SINK[0] = s[0];
    }
};
template <class Epi, class Sched, bool ALIGN_EPI = false, bool SP2 = false>
__device__ __forceinline__ void gemm_phase(PG8_LAS unsigned char* lds, const Gemm g, const Sched& S, const Epi& E) {
    const int tid = threadIdx.x, wid = __builtin_amdgcn_readfirstlane(tid >> 6), lane = tid & 63, wr = wid >> 2, wc = wid & 3, fr = lane & 15, fq = lane >> 4;
    const int K = g.K, nt = K / BK, LD = g.ld ? g.ld : g.K, skt = g.split_kt ? g.split_kt : (1 << 30);
    unsigned voffA[2], voffB[2];
#pragma unroll
    for (int i = 0; i < 2; ++i) { int R, C; stage_rc(tid * 16 + i * 8192, R, C); const int Rb = Epi::PERM ? ((R & ~31) + perm32(R & 31)) : R;
        voffA[i] = (unsigned)(R * LD + C) * 2u; voffB[i] = (unsigned)(Rb * LD + C) * 2u; }
    const size_t kstep = (size_t)(BK * 2);
    const long adjA = g.splitA - (long)g.split_kt * (BK * 2), adjB = g.splitB - (long)g.split_kt * (BK * 2);
    const size_t hstep = (size_t)HALF * LD * 2;
    const size_t tstep = 2 * hstep;
    const unsigned ldsw = (unsigned)wid * 1024u;
    const int aoff = lds_byte(wr * 64 + fr, fq * 8), boff = lds_byte(wc * 32 + fr, fq * 8);
#define PG8_SA(b, h) (((b) * 2 + (h)) * HTB)
#define PG8_SB(b, h) ((4 + (b) * 2 + (h)) * HTB)
#define PG8_STAGE(bufoff, gbase, voff) do { _Pragma("unroll") for (int _i = 0; _i < 2; ++_i) \
        __builtin_amdgcn_global_load_lds((const unsigned*)((const char*)(gbase) + (voff)[_i]), (PG8_LAS unsigned*)(lds + (bufoff) + ldsw + _i * 8192), 16, 0, 0); } while (0)
#define PG8_LDA(dst, b, h) do { _Pragma("unroll") for (int m = 0; m < 4; ++m) _Pragma("unroll") for (int k = 0; k < 2; ++k) dst[m][k] = *(const PG8_LAS bf16x8*)(lds + PG8_SA(b, h) + aoff + m * 2048 + k * 1024); } while (0)
#define PG8_LDB(dst, b, h) do { _Pragma("unroll") for (int n = 0; n < 2; ++n) _Pragma("unroll") for (int k = 0; k < 2; ++k) dst[n][k] = *(const PG8_LAS bf16x8*)(lds + PG8_SB(b, h) + boff + n * 2048 + k * 1024); } while (0)
#define PG8_MMA(ai, bj, At, Bt) do { __builtin_amdgcn_s_setprio(1); _Pragma("unroll") for (int m = 0; m < 4; ++m) _Pragma("unroll") for (int n = 0; n < 2; ++n) _Pragma("unroll") for (int k = 0; k < 2; ++k) \
        acc[ai][bj][m][n] = __builtin_amdgcn_mfma_f32_16x16x32_bf16(Bt[n][k], At[m][k], acc[ai][bj][m][n], 0, 0, 0); __builtin_amdgcn_s_setprio(0); } while (0)
#define PG8_WAIT_V(n) asm volatile("s_waitcnt vmcnt(" #n ")" ::: "memory")
#define PG8_WAIT_L(n) asm volatile("s_waitcnt lgkmcnt(" #n ")" ::: "memory")
#define PG8_BAR __builtin_amdgcn_s_barrier()
#define PG8_SCHED __builtin_amdgcn_sched_barrier(0)
    Unit cur, nxt; int ui = 0;
    if (!S.next(0, cur)) return;
    f32x4 acc[2][2][4][2];
#pragma unroll
    for (int a = 0; a < 2; ++a)
#pragma unroll
        for (int b = 0; b < 2; ++b)
#pragma unroll
            for (int m = 0; m < 4; ++m)
#pragma unroll
                for (int n = 0; n < 2; ++n) acc[a][b][m][n] = (f32x4){0.f, 0.f, 0.f, 0.f};
    bf16x8 At[4][2], B0[2][2], B1[2][2];
    const char* cA = (const char*)g.A + (size_t)cur.pm * tstep; const char* cB = (const char*)g.Bt + (size_t)cur.pn * tstep;
    S.a_ready(cur);
    if constexpr (SP2) {
        PG8_STAGE(PG8_SB(0, 0), cB, voffB); PG8_STAGE(PG8_SB(0, 1), cB + hstep, voffB); PG8_STAGE(PG8_SA(0, 0), cA, voffA); PG8_STAGE(PG8_SA(0, 1), cA + hstep, voffA);
        if (wr == 1) PG8_BAR;
        PG8_WAIT_V(2); PG8_BAR;
        PG8_STAGE(PG8_SB(1, 0), cB + kstep, voffB); PG8_STAGE(PG8_SA(1, 0), cA + kstep, voffA); PG8_STAGE(PG8_SB(1, 1), cB + hstep + kstep, voffB);
        PG8_WAIT_V(6); PG8_BAR;
    } else {
        PG8_STAGE(PG8_SB(0, 0), cB, voffB); PG8_STAGE(PG8_SA(0, 0), cA, voffA); PG8_STAGE(PG8_SB(0, 1), cB + hstep, voffB); PG8_STAGE(PG8_SA(0, 1), cA + hstep, voffA);
        if (wr == 1) PG8_BAR;
        PG8_WAIT_V(4); PG8_BAR;
        PG8_STAGE(PG8_SB(1, 0), cB + kstep, voffB); PG8_STAGE(PG8_SA(1, 0), cA + kstep, voffA); PG8_STAGE(PG8_SB(1, 1), cB + hstep + kstep, voffB);
        PG8_WAIT_V(6); PG8_BAR;
    }
    for (;;) {
        const bool has_next = S.next(ui + 1, nxt);
        const char* nA = has_next ? (const char*)g.A + (size_t)nxt.pm * tstep : cA; const char* nB = has_next ? (const char*)g.Bt + (size_t)nxt.pn * tstep : cB;
        for (int t = 0; t < nt; t += 2) {
            const bool last = (t == nt - 2);
            const char* a1 = cA + (size_t)(t + 1) * kstep + (t + 1 >= skt ? adjA : 0);
            const char* a2 = last ? nA : cA + (size_t)(t + 2) * kstep + (t + 2 >= skt ? adjA : 0); const char* b2 = last ? nB : cB + (size_t)(t + 2) * kstep + (t + 2 >= skt ? adjB : 0);
            if constexpr (Epi::HAS_MID) { if (t == skt) E.mid(acc, cur, wr, wc, fr, fq); }
            const char* a3 = a2 + kstep; const char* b3 = b2 + kstep;
            if (last && has_next) S.a_ready(nxt);
            if constexpr (SP2) {
            PG8_LDB(B0, 0, 0); PG8_LDB(B1, 0, 1); PG8_SCHED; PG8_LDA(At, 0, 0); PG8_STAGE(PG8_SA(1, 1), a1 + hstep, voffA);
            PG8_WAIT_V(8); PG8_WAIT_L(0); PG8_BAR; PG8_MMA(0, 0, At, B0); PG8_MMA(0, 1, At, B1); PG8_BAR; PG8_SCHED;
            PG8_LDA(At, 0, 1); PG8_STAGE(PG8_SB(0, 0), b2, voffB); PG8_STAGE(PG8_SB(0, 1), b2 + hstep, voffB); PG8_STAGE(PG8_SA(0, 0), a2, voffA);
            PG8_WAIT_V(8); PG8_WAIT_L(0); PG8_BAR; PG8_MMA(1, 0, At, B0); PG8_MMA(1, 1, At, B1); PG8_BAR; PG8_SCHED;
            PG8_LDB(B0, 1, 0); PG8_LDB(B1, 1, 1); PG8_SCHED; PG8_LDA(At, 1, 0); PG8_STAGE(PG8_SA(0, 1), a2 + hstep, voffA);
            PG8_WAIT_V(8); PG8_WAIT_L(0); PG8_BAR; PG8_MMA(0, 0, At, B0); PG8_MMA(0, 1, At, B1); PG8_BAR; PG8_SCHED;
            PG8_LDA(At, 1, 1); PG8_STAGE(PG8_SB(1, 0), b3, voffB); PG8_STAGE(PG8_SB(1, 1), b3 + hstep, voffB); PG8_STAGE(PG8_SA(1, 0), a3, voffA);
            PG8_WAIT_V(8); PG8_WAIT_L(0); PG8_BAR; PG8_MMA(1, 0, At, B0); PG8_MMA(1, 1, At, B1); PG8_BAR; PG8_SCHED;
            } else {
            PG8_LDB(B0, 0, 0); PG8_SCHED; PG8_LDA(At, 0, 0); PG8_STAGE(PG8_SA(1, 1), a1 + hstep, voffA);
            PG8_WAIT_L(8); PG8_BAR; PG8_WAIT_L(0); PG8_MMA(0, 0, At, B0); PG8_BAR; PG8_SCHED;
            PG8_LDB(B1, 0, 1); PG8_STAGE(PG8_SB(0, 0), b2, voffB);
            PG8_BAR; PG8_WAIT_L(0); PG8_MMA(0, 1, At, B1); PG8_BAR;
            PG8_LDA(At, 0, 1); PG8_STAGE(PG8_SA(0, 0), a2, voffA);
            PG8_BAR; PG8_WAIT_L(0); PG8_MMA(1, 0, At, B0); PG8_BAR; PG8_SCHED;
            PG8_STAGE(PG8_SB(0, 1), b2 + hstep, voffB);
            PG8_WAIT_V(6); PG8_BAR; PG8_MMA(1, 1, At, B1); PG8_BAR;
            PG8_LDB(B0, 1, 0); PG8_SCHED; PG8_LDA(At, 1, 0); PG8_STAGE(PG8_SA(0, 1), a2 + hstep, voffA);
            PG8_WAIT_L(8); PG8_BAR; PG8_WAIT_L(0); PG8_MMA(0, 0, At, B0); PG8_BAR; PG8_SCHED;
            PG8_LDB(B1, 1, 1); PG8_STAGE(PG8_SB(1, 0), b3, voffB);
            PG8_BAR; PG8_WAIT_L(0); PG8_MMA(0, 1, At, B1); PG8_BAR;
            PG8_LDA(At, 1, 1); PG8_STAGE(PG8_SA(1, 0), a3, voffA);
            PG8_BAR; PG8_WAIT_L(0); PG8_MMA(1, 0, At, B0); PG8_BAR; PG8_SCHED;
            PG8_STAGE(PG8_SB(1, 1), b3 + hstep, voffB);
            PG8_WAIT_V(6); PG8_BAR; PG8_MMA(1, 1, At, B1); PG8_BAR;
            }
        }
        if constexpr (ALIGN_EPI) { if (wr == 0) PG8_BAR; }
        if constexpr (!Epi::AFTER_DRAIN) { E(acc, cur, wr, wc, fr, fq); S.done(cur); }
        if (!has_next) break;
#pragma unroll
        for (int a = 0; a < 2; ++a)
#pragma unroll
            for (int b = 0; b < 2; ++b)
#pragma unroll
                for (int m = 0; m < 4; ++m)
#pragma unroll
                    for (int n = 0; n < 2; ++n) acc[a][b][m][n] = (f32x4){0.f, 0.f, 0.f, 0.f};
        cur = nxt; cA = nA; cB = nB; ++ui;
        if constexpr (ALIGN_EPI) { if (wr == 1) PG8_BAR; }
    }
    PG8_WAIT_V(0);
    if constexpr (!ALIGN_EPI) { if (wr == 0) PG8_BAR; }
    PG8_BAR;
    if constexpr (Epi::AFTER_DRAIN) { E.fused(acc, cur, wr, wc, fr, fq, lds, wid, lane); S.done(cur); }
#undef PG8_SA
#undef PG8_SB
#undef PG8_STAGE
#undef PG8_LDA
#undef PG8_LDB
#undef PG8_MMA
#undef PG8_WAIT_V
#undef PG8_WAIT_L
#undef PG8_BAR
#undef PG8_SCHED
}
}

#ifndef MK_N_LAUNCHES
#define MK_N_LAUNCHES 1
#endif
namespace cg = cooperative_groups;
#define LAS __attribute__((address_space(3)))
#define DI __device__ __forceinline__
typedef unsigned short bf16;
typedef float f32x4 __attribute__((ext_vector_type(4)));
typedef float f32x2 __attribute__((ext_vector_type(2)));
typedef short bf16x8 __attribute__((ext_vector_type(8)));
typedef unsigned u32x4 __attribute__((ext_vector_type(4)));
typedef unsigned u32x2 __attribute__((ext_vector_type(2)));

constexpr int T = 32768, D = 1024, SEQ = 8192, DIN = 8192, FF = 4096;
constexpr float EPS = 1e-6f;
constexpr int NPHASES = 8;
constexpr int LDS_MISC = 131072;
constexpr int LDS_BYTES = 139264;

constexpr size_t MiB = 1u << 20;
constexpr size_t WS_WIN = 0;
constexpr size_t WS_L   = 0;
constexpr size_t WS_WA  = 16 * MiB;
constexpr size_t WS_WB  = 18 * MiB;
constexpr size_t WS_WO  = 20 * MiB;
constexpr size_t WS_WMI = 22 * MiB;
constexpr size_t WS_WMO = 30 * MiB;
constexpr size_t WS_SS  = 38 * MiB;
constexpr size_t WS_LB  = 40 * MiB;
constexpr size_t WS_DSEG = 40 * MiB + 65536;
constexpr size_t WS_CTL = 41 * MiB, CTL_CNT = 16384, CTL_SS2 = 65536, CTL_BYTES = 196608;
constexpr size_t WS_RINV = 42 * MiB;
constexpr size_t WS_END = 512 * MiB;
constexpr size_t SLOT = 64 * MiB;
constexpr size_t S_V = 1 * SLOT, S_U = 2 * SLOT, S_H = 3 * SLOT, S_LF = 4 * SLOT, S_GS = 5 * SLOT, S_GA = 6 * SLOT, S_GB = 7 * SLOT;
constexpr size_t S_X1B = S_V, S_OA = S_U, S_UB = S_H, S_MG = S_LF, S_ZZ = 2 * SLOT;

struct Args { const float* in[16]; float* out; unsigned char* ws; int ph_lo, ph_hi, sync_mode, pad; };

DI float wave_sum(float v) {
#pragma unroll
    for (int o = 1; o < 64; o <<= 1) v += __shfl_xor(v, o);
    return v;
}
DI unsigned f2bf(float f) { unsigned u = __builtin_bit_cast(unsigned, f); return (u + 0x7fffu + ((u >> 16) & 1u)) >> 16; }
typedef __bf16 bf16x2_t __attribute__((ext_vector_type(2)));
DI unsigned pk2(float lo, float hi) { f32x2 v = {lo, hi}; bf16x2_t b = __builtin_convertvector(v, bf16x2_t); return __builtin_bit_cast(unsigned, b); }
DI float bflo(unsigned w) { return __uint_as_float(w << 16); }
DI float bfhi(unsigned w) { return __uint_as_float(w & 0xffff0000u); }
DI float ex2(float x) { return __builtin_amdgcn_exp2f(x); }

DI void p0_transpose_item(const float* W, int K, int N, bf16* WT, int k0, int n0, int src_n0, const float* kscale, LAS float* scr, int lane) {
    float wv[32];
#pragma unroll
    for (int i = 0; i < 32; ++i) wv[i] = __builtin_nontemporal_load(W + (size_t)(k0 + 2 * i + (lane >> 5)) * N + src_n0 + (lane & 31));
#pragma unroll
    for (int i = 0; i < 32; ++i) { const int kk = 2 * i + (lane >> 5); float v = wv[i]; if (kscale) v *= kscale[k0 + kk]; scr[kk * 33 + (lane & 31)] = v; }
    asm volatile("s_waitcnt lgkmcnt(0)" ::: "memory");
    const int c = lane & 7;
#pragma unroll
    for (int j = 0; j < 4; ++j) { const int n = (lane >> 3) + 8 * j; const LAS float* s = scr + (8 * c) * 33 + n;
        u32x4 o; o.x = pk2(s[0 * 33], s[1 * 33]); o.y = pk2(s[2 * 33], s[3 * 33]); o.z = pk2(s[4 * 33], s[5 * 33]); o.w = pk2(s[6 * 33], s[7 * 33]);
        *(u32x4*)(WT + (size_t)(n0 + n) * K + k0 + 8 * c) = o; }
    asm volatile("s_waitcnt lgkmcnt(0)" ::: "memory");
}
DI void p0_matrix(const float* W, int K, int N, bf16* WT, const float* kscale, bool glu, LAS float* scr, int gw, int ngw, int lane) {
    const int nblk = N / 32, items = (K / 64) * nblk;
    for (int it = gw; it < items; it += ngw) { const int kb = it / nblk, nb = it % nblk; const int n0 = nb * 32; int src = n0;
        if (glu) {
            const int tile = n0 >> 8, r = n0 & 255;
            if (tile < 4) src = n0;
            else if (tile < 8) src = 3072 + (n0 - 1024);
            else if (tile < 12) src = 1024 + (n0 - 2048);
            else if (tile < 16) src = 4096 + (r >> 7) * 1024 + 128 * (tile - 12) + (r & 127);
            else if (tile < 20) src = 2048 + (n0 - 4096);
            else if (tile < 24) src = 4096 + (r >> 7) * 1024 + 128 * (tile - 20 + 4) + (r & 127);
            else src = 6144 + (r >> 7) * 1024 + 128 * (tile - 24) + (r & 127); }
        p0_transpose_item(W, K, N, WT, kb * 64, n0, src, kscale, scr, lane); }
}
DI void p0_prologue(const Args& a, LAS unsigned char* lds, int G, int tid, int lane, int wave) {
    LAS float* scr = (LAS float*)(lds + wave * 16384);
    const int gw = blockIdx.x * 8 + wave, ngw = G * 8;
    unsigned char* ws = a.ws;
    p0_matrix(a.in[2], D, DIN, (bf16*)(ws + WS_WIN), nullptr, true, scr, gw, ngw, lane);
    if (blockIdx.x == 0) { const float* lp = a.in[3]; float* LB = (float*)(ws + WS_LB);
        for (int c = tid; c < 1024; c += 512) LB[c] = 1.0f / (1.0f + __expf(lp[1024 + c] - lp[c])); }
    const float* x = a.in[0]; const float* g1 = a.in[1]; bf16* H = (bf16*)(ws + S_H);
    f32x4 gv[4];
#pragma unroll
    for (int j = 0; j < 4; ++j) gv[j] = *(const f32x4*)(g1 + 4 * lane + 256 * j);
    f32x4 nxv[4], nyv[4];
    if (gw < T) {
#pragma unroll
        for (int j = 0; j < 4; ++j) nxv[j] = __builtin_nontemporal_load((const f32x4*)(x + (size_t)gw * D) + lane + 64 * j); }
    if (gw + ngw < T) {
#pragma unroll
        for (int j = 0; j < 4; ++j) nyv[j] = __builtin_nontemporal_load((const f32x4*)(x + (size_t)(gw + ngw) * D) + lane + 64 * j); }
    for (int m = gw; m < T; m += ngw) { f32x4 v[4]; float s = 0.f;
#pragma unroll
        for (int j = 0; j < 4; ++j) { v[j] = nxv[j]; nxv[j] = nyv[j]; }
        if (m + 2 * ngw < T) {
#pragma unroll
            for (int j = 0; j < 4; ++j) nyv[j] = __builtin_nontemporal_load((const f32x4*)(x + (size_t)(m + 2 * ngw) * D) + lane + 64 * j); }
#pragma unroll
        for (int j = 0; j < 4; ++j) s += (v[j].x * v[j].x + v[j].y * v[j].y) + (v[j].z * v[j].z + v[j].w * v[j].w);
        const float rms = sqrtf(wave_sum(s) * (1.0f / D) + EPS), rstd = 1.0f / rms; if (lane == 0) ((float*)(ws + WS_RINV))[m] = rms;
        u32x2* o = (u32x2*)(H + (size_t)m * D) + lane;
#pragma unroll
        for (int j = 0; j < 4; ++j) { u32x2 w; w.x = pk2(v[j].x * rstd * gv[j].x, v[j].y * rstd * gv[j].y); w.y = pk2(v[j].z * rstd * gv[j].z, v[j].w * rstd * gv[j].w); o[64 * j] = w; } }
}

DI void late_weights(const Args& a, LAS unsigned char* lds, int G, int lane, int wave) {
    LAS float* scr = (LAS float*)(lds + wave * 16384);
    const int gw = blockIdx.x * 8 + wave, ngw = G * 8;
    unsigned char* ws = a.ws;
    p0_matrix(a.in[5], D, D, (bf16*)(ws + WS_WA), nullptr, false, scr, gw, ngw, lane);
    p0_matrix(a.in[10], D, D, (bf16*)(ws + WS_WB), nullptr, false, scr, gw, ngw, lane);
    p0_matrix(a.in[11], D, D, (bf16*)(ws + WS_WO), nullptr, false, scr, gw, ngw, lane);
    p0_matrix(a.in[13], D, FF, (bf16*)(ws + WS_WMI), a.in[12], false, scr, gw, ngw, lane);
    p0_matrix(a.in[14], FF, D, (bf16*)(ws + WS_WMO), nullptr, false, scr, gw, ngw, lane);
}

constexpr int HQ_QT = 0, HQ_KT = 17408, HQ_KDT = 34816, HQ_VT = 53248, HQ_PP = 71680, HQ_ST = 80896, HQ_TOT = 115712, HQ_DV = 119808, HQ_SSQ = 120320;
constexpr int PA = 272, PB = 144;
DI bf16x8 ldfrag(const LAS unsigned char* base, int pitch, int row0, int k0, int lane) {
    return *(const LAS bf16x8*)(base + (row0 + (lane & 15)) * pitch + (k0 + 8 * (lane >> 4)) * 2);
}
#define MFMA16(a, b, c) __builtin_amdgcn_mfma_f32_16x16x32_bf16((a), (b), (c), 0, 0, 0)

template <bool PASS2>
DI void hgrn_unit(LAS unsigned char* lds, const Args& a, int unit, int tid, int lane, int w) {
    unsigned char* ws = a.ws;
    const bf16* Qb = (const bf16*)a.out;
    const bf16* Vb = (const bf16*)(ws + S_V); const bf16* LFb = (const bf16*)(ws + S_LF); const bf16* GSb = (const bf16*)(ws + S_GS); bf16* OA = (bf16*)(ws + S_OA);
    float* Lst = (float*)(ws + WS_L); float* DSEG = (float*)(ws + WS_DSEG); const float* HG = a.in[4];
    const int bh = unit >> 3, seg = unit & 7, b = bh >> 3, h = bh & 7;
    const size_t tok0 = (size_t)b * SEQ + (size_t)seg * 1024; const int cb = h * 128;
    const int fr = lane & 15, fq = lane >> 4;
    LAS float* TOT = (LAS float*)(lds + HQ_TOT); LAS float* DV = (LAS float*)(lds + HQ_DV); LAS float* SSQ = (LAS float*)(lds + HQ_SSQ);
    f32x4 S[8];
#pragma unroll
    for (int n = 0; n < 8; ++n) S[n] = (f32x4){0.f, 0.f, 0.f, 0.f};
    float segtot0 = 0.f, segtot1 = 0.f;
    const f32x2 lbv = *(const f32x2*)((const float*)(ws + WS_LB) + cb + 2 * lane); const f32x2 omlv = (f32x2){1.0f - lbv.x, 1.0f - lbv.y};
    f32x2 gh = (f32x2){1.f, 1.f};
    if (PASS2) {
        gh = *(const f32x2*)(HG + 2 * lane);
        float Lr[32], Dr[4];
#define HG_LLOAD(ii) do { const float* Li_ = Lst + (size_t)(bh * 8 + (ii)) * 16384 + (16 * w + 4 * fq) * 128 + fr; const float* Di_ = DSEG + (bh * 8 + (ii)) * 128 + 16 * w + 4 * fq; \
            _Pragma("unroll") for (int r = 0; r < 4; ++r) Dr[r] = Di_[r]; \
            _Pragma("unroll") for (int n = 0; n < 8; ++n) _Pragma("unroll") for (int r = 0; r < 4; ++r) Lr[n * 4 + r] = Li_[r * 128 + 16 * n]; } while (0)
        if (seg > 0) HG_LLOAD(0);
        for (int i = 0; i < seg; ++i) { float Lc[32], dd[4];
#pragma unroll
            for (int r = 0; r < 4; ++r) dd[r] = ex2(Dr[r]);
#pragma unroll
            for (int k = 0; k < 32; ++k) Lc[k] = Lr[k];
            if (i + 1 < seg) HG_LLOAD(i + 1);
#pragma unroll
            for (int n = 0; n < 8; ++n)
#pragma unroll
                for (int r = 0; r < 4; ++r) S[n][r] = S[n][r] * dd[r] + Lc[n * 4 + r]; }
#undef HG_LLOAD
#pragma unroll
        for (int n = 0; n < 8; ++n) { u32x2 pk; pk.x = pk2(S[n][0], S[n][1]); pk.y = pk2(S[n][2], S[n][3]); *(LAS u32x2*)(lds + HQ_ST + (16 * n + fr) * PA + (16 * w + 4 * fq) * 2) = pk; }
    }
    unsigned nlf[8], nv[8], nq[8], ngs[8];
#define HG_LOAD(cc) do { const size_t rb_ = tok0 + (size_t)(cc) * 64 + 8 * w; _Pragma("unroll") for (int i = 0; i < 8; ++i) { const size_t off = (rb_ + i) * D + cb + 2 * lane; \
            nlf[i] = *(const unsigned*)(LFb + off); nv[i] = *(const unsigned*)(Vb + off); if (PASS2) { nq[i] = *(const unsigned*)(Qb + off); ngs[i] = *(const unsigned*)(GSb + off); } } } while (0)
    HG_LOAD(0);
    for (int c = 0; c < 16; ++c) {
        unsigned vr[8], qr[8], gsc[8];
#pragma unroll
        for (int i = 0; i < 8; ++i) { vr[i] = nv[i]; if (PASS2) { qr[i] = nq[i]; gsc[i] = ngs[i]; } }
        f32x2 pl[8], kf[8]; f32x2 run = (f32x2){1.f, 1.f};
#pragma unroll
        for (int i = 0; i < 8; ++i) { const pg8::f16x2 hv = __builtin_bit_cast(pg8::f16x2, nlf[i]); const f32x2 s2 = (f32x2){(float)hv.x, (float)hv.y};
            run = run * (lbv + omlv * s2); pl[i] = run; kf[i] = omlv - omlv * s2; }
        *(LAS f32x2*)(TOT + w * 128 + 2 * lane) = run;
        __syncthreads();
        f32x2 pre = (f32x2){1.f, 1.f}, tot = (f32x2){1.f, 1.f};
#pragma unroll
        for (int ww = 0; ww < 8; ++ww) { const f32x2 t = *(const LAS f32x2*)(TOT + ww * 128 + 2 * lane); tot = tot * t; if (ww < w) pre = pre * t; }
        segtot0 += __builtin_amdgcn_logf(tot.x); segtot1 += __builtin_amdgcn_logf(tot.y);
        unsigned kd0[4], kd1[4];
#pragma unroll
        for (int i = 0; i < 8; i += 2) {
            f32x2 kd[2];
#pragma unroll
            for (int e = 0; e < 2; ++e) { const int ii = i + e; f32x2 E = pre * pl[ii]; E.x = fmaxf(E.x, 2.4e-35f); E.y = fmaxf(E.y, 2.4e-35f);
                const f32x2 inv = (f32x2){__builtin_amdgcn_rcpf(E.x), __builtin_amdgcn_rcpf(E.y)}; const f32x2 kt = kf[ii] * inv; kd[e] = kt * tot;
                if (PASS2) { const f32x2 q2 = (f32x2){bflo(qr[ii]), bfhi(qr[ii])} * E;
                    *(LAS unsigned*)(lds + HQ_QT + (8 * w + ii) * PA + 4 * lane) = pk2(q2.x, q2.y);
                    *(LAS unsigned*)(lds + HQ_KT + (8 * w + ii) * PA + 4 * lane) = pk2(kt.x, kt.y); } }
            kd0[i >> 1] = pk2(kd[0].x, kd[1].x); kd1[i >> 1] = pk2(kd[0].y, kd[1].y); }
        *(LAS u32x4*)(lds + HQ_KDT + (2 * lane) * PB + 16 * w) = (u32x4){kd0[0], kd0[1], kd0[2], kd0[3]};
        *(LAS u32x4*)(lds + HQ_KDT + (2 * lane + 1) * PB + 16 * w) = (u32x4){kd1[0], kd1[1], kd1[2], kd1[3]};
        { u32x4 v0, v1;
          v0.x = (vr[0] & 0xffffu) | (vr[1] << 16); v0.y = (vr[2] & 0xffffu) | (vr[3] << 16); v0.z = (vr[4] & 0xffffu) | (vr[5] << 16); v0.w = (vr[6] & 0xffffu) | (vr[7] << 16);
          v1.x = (vr[0] >> 16) | (vr[1] & 0xffff0000u); v1.y = (vr[2] >> 16) | (vr[3] & 0xffff0000u); v1.z = (vr[4] >> 16) | (vr[5] & 0xffff0000u); v1.w = (vr[6] >> 16) | (vr[7] & 0xffff0000u);
          *(LAS u32x4*)(lds + HQ_VT + (2 * lane) * PB + 16 * w) = v0; *(LAS u32x4*)(lds + HQ_VT + (2 * lane + 1) * PB + 16 * w) = v1; }
        if (w == 0) *(LAS f32x2*)(DV + 2 * lane) = tot;
        __syncthreads();
        if (c < 15) HG_LOAD(c + 1);
        if (PASS2) {
            const int tt = w & 3;
#pragma unroll
            for (int e = 0; e < 2; ++e) { const int st = 2 * (w >> 2) + e; f32x4 sc = (f32x4){0.f, 0.f, 0.f, 0.f};
                if (st <= tt) {
#pragma unroll
                    for (int ks = 0; ks < 4; ++ks) sc = MFMA16(ldfrag(lds + HQ_KT, PA, 16 * st, 32 * ks, lane), ldfrag(lds + HQ_QT, PA, 16 * tt, 32 * ks, lane), sc); }
                const int t = 16 * tt + fr, s0 = 16 * st + 4 * fq;
#pragma unroll
                for (int r = 0; r < 4; ++r) if (s0 + r > t) sc[r] = 0.f;
                u32x2 pk; pk.x = pk2(sc[0], sc[1]); pk.y = pk2(sc[2], sc[3]);
                *(LAS u32x2*)(lds + HQ_PP + t * PB + s0 * 2) = pk; }
            __syncthreads();
            const int mt = w & 3; f32x4 o[4];
#pragma unroll
            for (int j = 0; j < 4; ++j) o[j] = (f32x4){0.f, 0.f, 0.f, 0.f};
#pragma unroll
            for (int ks = 0; ks < 4; ++ks) { const bf16x8 bq = ldfrag(lds + HQ_QT, PA, 16 * mt, 32 * ks, lane);
#pragma unroll
                for (int j = 0; j < 4; ++j) o[j] = MFMA16(ldfrag(lds + HQ_ST, PA, 16 * (4 * (w >> 2) + j), 32 * ks, lane), bq, o[j]); }
#pragma unroll
            for (int ks = 0; ks < 2; ++ks) { const bf16x8 bp = ldfrag(lds + HQ_PP, PB, 16 * mt, 32 * ks, lane);
#pragma unroll
                for (int j = 0; j < 4; ++j) o[j] = MFMA16(ldfrag(lds + HQ_VT, PB, 16 * (4 * (w >> 2) + j), 32 * ks, lane), bp, o[j]); }
            float q = 0.f;
#pragma unroll
            for (int j = 0; j < 4; ++j) q += (o[j][0] * o[j][0] + o[j][1] * o[j][1]) + (o[j][2] * o[j][2] + o[j][3] * o[j][3]);
            q += __shfl_xor(q, 16); q += __shfl_xor(q, 32);
            if (fq == 0) SSQ[(16 * mt + fr) * 2 + (w >> 2)] = q;
            __syncthreads();
            { const f32x2 s2 = *(const LAS f32x2*)(SSQ + (16 * mt + fr) * 2); const float rstd = 1.0f / sqrtf((s2.x + s2.y) * (1.0f / 128.0f) + EPS);
#pragma unroll
              for (int j = 0; j < 4; ++j) { u32x2 pk; pk.x = pk2(o[j][0] * rstd, o[j][1] * rstd); pk.y = pk2(o[j][2] * rstd, o[j][3] * rstd);
                  *(LAS u32x2*)(lds + HQ_KT + (16 * mt + fr) * PA + (16 * (4 * (w >> 2) + j) + 4 * fq) * 2) = pk; } }
            __syncthreads();
#pragma unroll
            for (int i = 0; i < 8; ++i) { const unsigned ot = *(const LAS unsigned*)(lds + HQ_KT + (8 * w + i) * PA + 4 * lane);
                *(unsigned*)(OA + (tok0 + (size_t)c * 64 + 8 * w + i) * D + cb + 2 * lane) = pk2(bflo(ot) * gh.x * bflo(gsc[i]), bfhi(ot) * gh.y * bfhi(gsc[i])); }
        }
        { float dd[4];
#pragma unroll
          for (int r = 0; r < 4; ++r) dd[r] = DV[16 * w + 4 * fq + r];
          const bf16x8 a0 = ldfrag(lds + HQ_KDT, PB, 16 * w, 0, lane), a1 = ldfrag(lds + HQ_KDT, PB, 16 * w, 32, lane);
#pragma unroll
          for (int n = 0; n < 8; ++n) {
#pragma unroll
              for (int r = 0; r < 4; ++r) S[n][r] *= dd[r];
              S[n] = MFMA16(a0, ldfrag(lds + HQ_VT, PB, 16 * n, 0, lane), S[n]); S[n] = MFMA16(a1, ldfrag(lds + HQ_VT, PB, 16 * n, 32, lane), S[n]); }
          if (PASS2) {
#pragma unroll
              for (int n = 0; n < 8; ++n) { u32x2 pk; pk.x = pk2(S[n][0], S[n][1]); pk.y = pk2(S[n][2], S[n][3]); *(LAS u32x2*)(lds + HQ_ST + (16 * n + fr) * PA + (16 * w + 4 * fq) * 2) = pk; } }
        }
    }
    if (!PASS2) { float* Lu = Lst + (size_t)unit * 16384;
#pragma unroll
        for (int n = 0; n < 8; ++n)
#pragma unroll
            for (int r = 0; r < 4; ++r) Lu[(16 * w + 4 * fq + r) * 128 + 16 * n + fr] = S[n][r];
        if (w == 0) *(f32x2*)(DSEG + unit * 128 + 2 * lane) = (f32x2){segtot0, segtot1}; }
    __syncthreads();
#undef HG_LOAD
}

DI void conv_tile(LAS unsigned char* lds, const Args& a, int tile, int tid, int lane, int w) {
    unsigned char* ws = a.ws; const bf16* U = (const bf16*)(ws + S_U); bf16* UB = (bf16*)a.out + (size_t)T * D;
    const float *CW = a.in[6], *CBs = a.in[7], *LG = a.in[8], *LBt = a.in[9];
    const int t0 = tile * 128, pos0 = t0 & (SEQ - 1), c2 = 2 * tid;
    LAS float* RED = (LAS float*)lds;
    f32x2 wreg[31];
    const float* cwp = CW + c2; asm volatile("" : "+v"(cwp));
#pragma unroll
    for (int j = 0; j < 31; ++j) wreg[j] = *(const f32x2*)(cwp + j * 1024);
    const f32x2 bias = *(const f32x2*)(CBs + c2), lng = *(const f32x2*)(LG + c2), lnb = *(const f32x2*)(LBt + c2);
    f32x2 win[34];
#pragma unroll
    for (int i = 0; i < 30; ++i) { unsigned wv = 0u; if (pos0 + i - 30 >= 0) wv = *(const unsigned*)(U + (size_t)(t0 + i - 30) * D + c2); win[i] = (f32x2){bflo(wv), bfhi(wv)}; }
    unsigned nx[16];
#pragma unroll
    for (int i = 0; i < 16; ++i) nx[i] = *(const unsigned*)(U + (size_t)(t0 + i) * D + c2);
    for (int g4 = 0; g4 < 8; ++g4)
#pragma unroll
    for (int gg = 0; gg < 4; ++gg) { const int g = g4 * 4 + gg;
#pragma unroll
        for (int i = 0; i < 4; ++i) win[30 + i] = (f32x2){bflo(nx[gg * 4 + i]), bfhi(nx[gg * 4 + i])};
        if (g4 < 7) {
#pragma unroll
            for (int i = 0; i < 4; ++i) nx[gg * 4 + i] = *(const unsigned*)(U + (size_t)(t0 + (g + 4) * 4 + i) * D + c2); }
        f32x2 y[4]; float av[8];
#pragma unroll
        for (int o = 0; o < 4; ++o) { f32x2 acc = bias;
#pragma unroll
            for (int j = 0; j < 31; ++j) acc += wreg[j] * win[o + j];
            y[o] = acc; av[2 * o] = acc.x + acc.y; av[2 * o + 1] = acc.x * acc.x + acc.y * acc.y; }
        float dsum;
        { const bool h32 = (lane & 32) != 0, h16 = (lane & 16) != 0, h8 = (lane & 8) != 0; float b4[4], c2[2];
#pragma unroll
          for (int k = 0; k < 4; ++k) { const float snd = h32 ? av[k] : av[4 + k], kp = h32 ? av[4 + k] : av[k]; b4[k] = kp + __shfl_xor(snd, 32); }
#pragma unroll
          for (int k = 0; k < 2; ++k) { const float snd = h16 ? b4[k] : b4[2 + k], kp = h16 ? b4[2 + k] : b4[k]; c2[k] = kp + __shfl_xor(snd, 16); }
          { const float snd = h8 ? c2[0] : c2[1], kp = h8 ? c2[1] : c2[0]; dsum = kp + __shfl_xor(snd, 8); }
          dsum += __shfl_xor(dsum, 4); dsum += __shfl_xor(dsum, 2); dsum += __shfl_xor(dsum, 1); }
        LAS float* red = RED + (g & 1) * 64;
        if ((lane & 7) == 0) { const int idx = lane >> 3; red[(idx >> 1) * 16 + w * 2 + (idx & 1)] = dsum; }
        __syncthreads();
#pragma unroll
        for (int o = 0; o < 4; ++o) { const f32x4 p0 = *(const LAS f32x4*)(red + o * 16), p1 = *(const LAS f32x4*)(red + o * 16 + 4), p2 = *(const LAS f32x4*)(red + o * 16 + 8), p3 = *(const LAS f32x4*)(red + o * 16 + 12);
            const float sm = ((p0.x + p0.z) + (p1.x + p1.z)) + ((p2.x + p2.z) + (p3.x + p3.z)), qm = ((p0.y + p0.w) + (p1.y + p1.w)) + ((p2.y + p2.w) + (p3.y + p3.w));
            const float mean = sm * (1.0f / 1024.0f), var = fmaxf(qm * (1.0f / 1024.0f) - mean * mean, 0.f), rstd = 1.0f / sqrtf(var + EPS);
            const float y0 = (y[o].x - mean) * rstd * lng.x + lnb.x, y1 = (y[o].y - mean) * rstd * lng.y + lnb.y;
            *(unsigned*)(UB + (size_t)(t0 + g * 4 + o) * D + c2) = pk2(y0 * pg8::sigm(y0), y1 * pg8::sigm(y1)); }
#pragma unroll
        for (int i = 0; i < 30; ++i) win[i] = win[i + 4];
    }
    __syncthreads();
}

DI void final_norm(const Args& a, int G, int lane, int wave) {
    const float* gf = a.in[15]; float* out = a.out; const int gw = blockIdx.x * 8 + wave, ngw = G * 8;
    f32x4 gv[4];
#pragma unroll
    for (int j = 0; j < 4; ++j) gv[j] = *(const f32x4*)(gf + 4 * lane + 256 * j);
    for (int m = gw; m < T; m += ngw) { f32x4* xr = (f32x4*)(out + (size_t)m * D) + lane; f32x4 v[4]; float s = 0.f;
#pragma unroll
        for (int j = 0; j < 4; ++j) { v[j] = xr[64 * j]; s += (v[j].x * v[j].x + v[j].y * v[j].y) + (v[j].z * v[j].z + v[j].w * v[j].w); }
        const float rstd = 1.0f / sqrtf(wave_sum(s) * (1.0f / D) + EPS);
#pragma unroll
        for (int j = 0; j < 4; ++j) xr[64 * j] = v[j] * rstd * gv[j]; }
}

#define XB_TMO      128
#define XB_XCNT(j)  (256  + 64 * (j))
#define XB_XSUB(j)  (1280 + 64 * (j))
#define XB_XGEN(j)  (2304 + 64 * (j))
#define XB_TOP      3328
#define XB_TOPGEN   3392
#define XCD_BAR_WORDS 3456
#define XB_SPIN_CAP (1u << 18)

__device__ __forceinline__ unsigned xb_ld(unsigned* p)              { return __hip_atomic_load(p, __ATOMIC_RELAXED, __HIP_MEMORY_SCOPE_AGENT); }
__device__ __forceinline__ unsigned xb_add(unsigned* p, unsigned v) { return __hip_atomic_fetch_add(p, v, __ATOMIC_RELAXED, __HIP_MEMORY_SCOPE_AGENT); }
__device__ __forceinline__ unsigned xb_xcc_id() { return (unsigned)__builtin_amdgcn_s_getreg((3 << 11) | 20) & 0xFu; }
#define XB_SPIN(cond, bar) do { unsigned _sp = 0; while (cond) { __builtin_amdgcn_s_sleep(1); \
    if ((++_sp & 255u) == 0u) { if (xb_ld(&(bar)[XB_TMO])) break; if (_sp > XB_SPIN_CAP) { atomicAdd(&(bar)[XB_TMO], 1u); break; } } } } while (0)

struct XcdBarrier {
    unsigned* bar; unsigned x;
    volatile LAS unsigned* st;
};

__device__ __forceinline__ XcdBarrier xcd_barrier_post(unsigned* bar, volatile LAS unsigned* st) {
    XcdBarrier b; b.bar = bar; b.x = xb_xcc_id(); b.st = st;
    if (threadIdx.x == 0) (void)xb_add(&bar[XB_XCNT(b.x)], 1u);
    return b;
}
__device__ __forceinline__ void xcd_barrier_complete(unsigned* bar, unsigned x, unsigned& nloc, unsigned& nx) {
    const unsigned G = gridDim.x * gridDim.y * gridDim.z;
    unsigned sum, cnt, mine, sp = 0u;
    for (;;) {
        sum = 0u; cnt = 0u; mine = 0u;
#pragma unroll
        for (unsigned j = 0; j < 16; ++j) { const unsigned c = xb_ld(&bar[XB_XCNT(j)]); sum += c; cnt += (c > 0u) ? 1u : 0u; mine = (j == x) ? c : mine; }
        if (sum == G) break;
        __builtin_amdgcn_s_sleep(1);
        if ((++sp & 255u) == 0u) { if (xb_ld(&bar[XB_TMO])) break; if (sp > XB_SPIN_CAP) { atomicAdd(&bar[XB_TMO], 1u); break; } }
    }
    nloc = mine > 0u ? mine : 1u; nx = cnt > 0u ? cnt : 1u;
}

__device__ __forceinline__ void xcd_barrier(const XcdBarrier& b) {
    asm volatile("s_waitcnt vmcnt(0)" ::: "memory");
    __syncthreads();
    if (threadIdx.x == 0) {
        unsigned* bar = b.bar;
        __builtin_amdgcn_s_waitcnt(0);
        unsigned nloc = b.st[0], nx = b.st[1];
        if (nloc == 0u) { xcd_barrier_complete(bar, b.x, nloc, nx); b.st[0] = nloc; b.st[1] = nx; }
        const unsigned old = xb_add(&bar[XB_XSUB(b.x)], 1u);
        const unsigned gen = old / nloc;
        if (old + 1u == (gen + 1u) * nloc) {
            __builtin_amdgcn_fence(__ATOMIC_RELEASE, "agent");
            asm volatile("s_waitcnt vmcnt(0)" ::: "memory");
            const unsigned og = xb_add(&bar[XB_TOP], 1u);
            const unsigned tg = og / nx;
            if (og + 1u == (tg + 1u) * nx) xb_add(&bar[XB_TOPGEN], 1u);
            else XB_SPIN(xb_ld(&bar[XB_TOPGEN]) == tg, bar);
            __builtin_amdgcn_fence(__ATOMIC_ACQUIRE, "agent");
            xb_add(&bar[XB_XGEN(b.x)], 1u);
            asm volatile("s_waitcnt vmcnt(0)" ::: "memory");
        } else {
            XB_SPIN(xb_ld(&bar[XB_XGEN(b.x)]) == gen, bar);
            __builtin_amdgcn_fence(__ATOMIC_ACQUIRE, "agent");
            asm volatile("s_waitcnt vmcnt(0)" ::: "memory");
        }
    }
    __syncthreads();
}

__global__ void __launch_bounds__(512, 2) fwd_megakernel(Args args) {
    extern __shared__ __attribute__((aligned(16))) unsigned char lds_raw[];
    LAS unsigned char* lds = (LAS unsigned char*)lds_raw;
    const int tid = threadIdx.x, lane = tid & 63, wave = __builtin_amdgcn_readfirstlane(tid >> 6);
    const int G = gridDim.x; unsigned char* ws = args.ws;
    const int lo = args.ph_lo, hi = args.ph_hi;
#define IN(k) (lo <= (k) && (k) < hi)
#ifndef PROBE_REP
#define PROBE_REP -1
#endif
#ifndef PGA
#define PGA true
#endif
#ifndef WGM_P1
#define WGM_P1 2
#endif
#ifndef WGM_P6
#define WGM_P6 2
#endif
#ifndef PGS
#define PGS true
#endif
    if (args.sync_mode != 0) cg::this_grid().sync();
    volatile LAS unsigned* xst = (volatile LAS unsigned*)(lds + LDS_MISC);
    if (tid < 2) xst[tid] = 0u;
    __syncthreads();
    XcdBarrier xbar = xcd_barrier_post((unsigned*)(ws + WS_CTL), xst);
#define SEAM(k) do { if (IN(k) && IN((k) + 1)) { xcd_barrier(xbar); if (PROBE_REP == 99) { xcd_barrier(xbar); } } } while (0)
#define REPS(k) for (int rep_ = 0; rep_ < (PROBE_REP == (k) ? 2 : 1); ++rep_)
    bf16* Qb = (bf16*)args.out; bf16* Kb = (bf16*)args.out + (size_t)T * D;

    if (IN(0)) REPS(0) { p0_prologue(args, lds, G, tid, lane, wave); __syncthreads(); }
    SEAM(0);
    if (IN(1)) {
        pg8::Gemm g{(const bf16*)(ws + S_H), (const bf16*)(ws + WS_WIN), T, DIN, D}; pg8::StaticOrder S; S.init(T, DIN, G, (int)blockIdx.x, WGM_P1); S.rot = 4;
        pg8::EpiIn E{Qb, Kb, (bf16*)(ws + S_V), (bf16*)(ws + S_GS), (bf16*)(ws + S_U), (bf16*)(ws + S_GA), (bf16*)(ws + S_GB), (bf16*)(ws + S_LF), (const float*)(ws + WS_LB)};
        pg8::gemm_phase<pg8::EpiIn, pg8::StaticOrder, false, PGS>(lds, g, S, E);
    }
#if PROBE_REP == 1
    if (IN(1)) {
        pg8::Gemm g{(const bf16*)(ws + S_H), (const bf16*)(ws + WS_WIN), T, DIN, D}; pg8::StaticOrder S; S.init(T, DIN, G, (int)blockIdx.x, WGM_P1); S.rot = 4;
        pg8::EpiIn E{Qb, Kb, (bf16*)(ws + S_V), (bf16*)(ws + S_GS), (bf16*)(ws + S_U), (bf16*)(ws + S_GA), (bf16*)(ws + S_GB), (bf16*)(ws + S_LF), (const float*)(ws + WS_LB)};
        pg8::gemm_phase<pg8::EpiIn, pg8::StaticOrder, false, PGS>(lds, g, S, E);
    }
#endif
    SEAM(1);
    if (IN(2)) {
        const bool conv_first = ((blockIdx.x >> 3) & 1) != 0;
        if (!conv_first) { REPS(20) for (int u = blockIdx.x; u < 256; u += G) if ((u & 7) != 7) hgrn_unit<false>(lds, args, u, tid, lane, wave); }
        REPS(21) for (int t = blockIdx.x; t < T / 128; t += G) conv_tile(lds, args, t, tid, lane, wave);
        if (conv_first) { REPS(20) for (int u = blockIdx.x; u < 256; u += G) if ((u & 7) != 7) hgrn_unit<false>(lds, args, u, tid, lane, wave); }
    }
    SEAM(2);
    if (IN(3)) REPS(3) {
        for (int u = blockIdx.x; u < 256; u += G) hgrn_unit<true>(lds, args, u, tid, lane, wave);
        late_weights(args, lds, G, lane, wave); __syncthreads();
    }
    SEAM(3);
    if (IN(4)) {
        pg8::Gemm g{(const bf16*)(ws + S_OA), (const bf16*)(ws + WS_WA), T, D, 2 * D, D, 16, (long)((const char*)((const bf16*)args.out + (size_t)T * D) - (const char*)(ws + S_OA)), (long)(WS_WB - WS_WA)}; pg8::StaticOrder S; S.init(T, D, G, (int)blockIdx.x);
        pg8::EpiMerge E{(bf16*)(ws + S_MG), (const bf16*)(ws + S_GA), (const bf16*)(ws + S_GB)};
        pg8::gemm_phase<pg8::EpiMerge, pg8::StaticOrder, PGA, PGS>(lds, g, S, E);
    }
#if PROBE_REP == 4
    if (IN(4)) {
        pg8::Gemm g{(const bf16*)(ws + S_OA), (const bf16*)(ws + WS_WA), T, D, 2 * D, D, 16, (long)((const char*)((const bf16*)args.out + (size_t)T * D) - (const char*)(ws + S_OA)), (long)(WS_WB - WS_WA)}; pg8::StaticOrder S; S.init(T, D, G, (int)blockIdx.x);
        pg8::EpiMerge E{(bf16*)(ws + S_MG), (const bf16*)(ws + S_GA), (const bf16*)(ws + S_GB)};
        pg8::gemm_phase<pg8::EpiMerge, pg8::StaticOrder, PGA, PGS>(lds, g, S, E);
    }
#endif
    SEAM(4);
    if (IN(5)) {
        pg8::Gemm g{(const bf16*)(ws + S_MG), (const bf16*)(ws + WS_WO), T, D, D}; pg8::StaticOrder S; S.init(T, D, G, (int)blockIdx.x);
        pg8::EpiX1 E{(const bf16*)(ws + S_H), (const float*)(ws + WS_RINV), args.in[1], (bf16*)(ws + S_X1B), (float*)(ws + WS_SS)};
        pg8::gemm_phase<pg8::EpiX1, pg8::StaticOrder, PGA, PGS>(lds, g, S, E);
    }
#if PROBE_REP == 5
    if (IN(5)) {
        pg8::Gemm g{(const bf16*)(ws + S_MG), (const bf16*)(ws + WS_WO), T, D, D}; pg8::StaticOrder S; S.init(T, D, G, (int)blockIdx.x);
        pg8::EpiX1 E{(const bf16*)(ws + S_H), (const float*)(ws + WS_RINV), args.in[1], (bf16*)(ws + S_X1B), (float*)(ws + WS_SS)};
        pg8::gemm_phase<pg8::EpiX1, pg8::StaticOrder, PGA, PGS>(lds, g, S, E);
    }
#endif
    SEAM(5);
    if (IN(6)) {
        pg8::Gemm g{(const bf16*)(ws + S_X1B), (const bf16*)(ws + WS_WMI), T, FF, D}; pg8::StaticOrder S; S.init(T, FF, G, (int)blockIdx.x, WGM_P6);
        pg8::EpiZZ E{(bf16*)(ws + S_ZZ), (const float*)(ws + WS_SS)};
        pg8::gemm_phase<pg8::EpiZZ, pg8::StaticOrder, PGA, PGS>(lds, g, S, E);
    }
#if PROBE_REP == 6
    if (IN(6)) {
        pg8::Gemm g{(const bf16*)(ws + S_X1B), (const bf16*)(ws + WS_WMI), T, FF, D}; pg8::StaticOrder S; S.init(T, FF, G, (int)blockIdx.x, WGM_P6);
        pg8::EpiZZ E{(bf16*)(ws + S_ZZ), (const float*)(ws + WS_SS)};
        pg8::gemm_phase<pg8::EpiZZ, pg8::StaticOrder, PGA, PGS>(lds, g, S, E);
    }
#endif
    SEAM(6);
#if PROBE_REP == 7
    if (IN(7)) {
        pg8::Gemm g{(const bf16*)(ws + S_ZZ), (const bf16*)(ws + WS_WMO), T, D, FF}; pg8::StaticOrder S; S.init(T, D, G, (int)blockIdx.x);
        pg8::EpiDry E{(float*)(ws + WS_SS)};
        pg8::gemm_phase<pg8::EpiDry, pg8::StaticOrder, PGA, PGS>(lds, g, S, E);
    }
#endif
#if PROBE_REP == 61
    if (IN(6)) {
        pg8::Gemm g{(const bf16*)(ws + S_X1B), (const bf16*)(ws + WS_WMI), T, FF, D}; pg8::StaticOrder S; S.init(T, FF, G, (int)blockIdx.x, WGM_P6);
        pg8::EpiDry E{(float*)(ws + WS_SS)};
        pg8::gemm_phase<pg8::EpiDry, pg8::StaticOrder, PGA, PGS>(lds, g, S, E);
    }
#endif
    if (IN(7)) {
        pg8::Gemm g{(const bf16*)(ws + S_ZZ), (const bf16*)(ws + WS_WMO), T, D, FF}; pg8::StaticOrder S; S.init(T, D, G, (int)blockIdx.x);
        pg8::EpiX2 E{(const bf16*)(ws + S_X1B), args.out, args.in[15], (float*)(ws + WS_CTL + CTL_SS2), (unsigned*)(ws + WS_CTL + CTL_CNT)};
        pg8::gemm_phase<pg8::EpiX2, pg8::StaticOrder, PGA, PGS>(lds, g, S, E);
    }
#undef IN
#undef SEAM
}

extern "C" void kernel_launch(void* const* d_in, const int* in_sizes, int n_in, void* d_out, int out_size, void* d_ws, size_t ws_size, hipStream_t stream) {
    static int grid = 0;
    if (grid == 0) {
        int dev = 0, cus = 0, per_cu = 0;
        hipGetDevice(&dev); hipDeviceGetAttribute(&cus, hipDeviceAttributeMultiprocessorCount, dev);
        hipFuncSetAttribute((const void*)fwd_megakernel, hipFuncAttributeMaxDynamicSharedMemorySize, LDS_BYTES);
        hipOccupancyMaxActiveBlocksPerMultiprocessor(&per_cu, (const void*)fwd_megakernel, 512, LDS_BYTES);
        if (per_cu < 1) { fprintf(stderr, "kernel_launch: occupancy query says %d blocks per CU\n", per_cu); per_cu = 1; }
        grid = cus * per_cu; if (grid > 256) grid = 256;
        if (ws_size < WS_END) fprintf(stderr, "kernel_launch: workspace %zu < %zu needed\n", ws_size, (size_t)WS_END);
    }
    hipMemsetAsync((unsigned char*)d_ws + WS_CTL, 0, CTL_BYTES, stream);
    Args a{};
    for (int i = 0; i < 16; ++i) a.in[i] = (const float*)d_in[i];
    a.out = (float*)d_out; a.ws = (unsigned char*)d_ws;
#if MK_N_LAUNCHES == 1
    a.ph_lo = 0; a.ph_hi = NPHASES;
    void* kargs[] = {&a};
    hipError_t e = hipLaunchCooperativeKernel((const void*)fwd_megakernel, dim3(grid), dim3(512), kargs, LDS_BYTES, stream);
    if (e != hipSuccess) fprintf(stderr, "cooperative launch failed: %s (grid %d)\n", hipGetErrorString(e), grid);
#else
    for (int p = 0; p < NPHASES; ++p) { a.ph_lo = p; a.ph_hi = p + 1; hipLaunchKernelGGL(fwd_megakernel, dim3(grid), dim3(512), LDS_BYTES, stream, a); }
#endif
}
```

```cpp
#include <hip/hip_runtime.h>
#include <hip/hip_cooperative_groups.h>
#include <cstdio>
#include <cstdint>
namespace pg8 {
#define PG8_LAS __attribute__((address_space(3)))
typedef unsigned short bf16_t;
typedef short bf16x8 __attribute__((ext_vector_type(8)));
typedef float f32x4 __attribute__((ext_vector_type(4)));
typedef unsigned u32x4 __attribute__((ext_vector_type(4)));
constexpr int BM = 256, BK = 64, HALF = 128, HTB = HALF * BK * 2  , STAGE_BYTES = 8 * HTB, NXCD = 8, WGM = 2;

__host__ __device__ __forceinline__ int lds_byte(int r, int c) { const int st = (r >> 4) * 2 + (c >> 5), rr = r & 15, cc = c & 31, ob = rr * 64 + cc * 2; return st * 1024 + (ob ^ (((ob >> 9) & 1) << 5)); }
__host__ __device__ __forceinline__ void stage_rc(int b, int& R, int& C) { const int st = b / 1024, sb = b % 1024, swz = sb ^ (((sb >> 9) & 1) << 5); R = (st >> 1) * 16 + swz / 64; C = (st & 1) * 32 + (swz % 64) / 2; }
__host__ __device__ __forceinline__ int perm32(int rho) { const int n = rho >> 4, i = rho & 15; return 8 * (i >> 2) + 4 * n + (i & 3); }

struct Unit { int pm, pn; };
struct Gemm { const bf16_t* A; const bf16_t* Bt; int M, N, K; int ld, split_kt; long splitA, splitB; };

struct StaticOrder {
    int nM, nN, nwg, G, c, wgm, rot;
    __host__ __device__ void init(int M, int N, int G_, int c_, int wgm_ = WGM) { nM = M / BM; nN = N / BM; nwg = nM * nN; G = G_; c = c_; wgm = wgm_; rot = 0; }
    __host__ __device__ bool next(int i, Unit& u) const {
        const long L = (long)i * G + c; if (L >= nwg) return false;
        int wgid = (int)L; { const int q = nwg / NXCD, r = nwg % NXCD, xcd = wgid % NXCD, off = wgid / NXCD; wgid = (xcd < r ? xcd * (q + 1) : r * (q + 1) + (xcd - r) * q) + off; }
        const int nig = wgm * nN, gid = wgid / nig, fm = gid * wgm, gsz = (nM - fm) < wgm ? (nM - fm) : wgm;
        u.pm = fm + ((wgid % nig) % gsz); u.pn = (wgid % nig) / gsz; if (rot) u.pn = (u.pn & ~15) | ((u.pn + rot * gid) & 15); return true;
    }
    __device__ __forceinline__ void a_ready(const Unit&) const {}
    __device__ __forceinline__ void done(const Unit&) const {}
};

__device__ __forceinline__ unsigned cvt_pk_bf16(float lo, float hi) { unsigned r; asm volatile("v_cvt_pk_bf16_f32 %0, %1, %2" : "=v"(r) : "v"(lo), "v"(hi)); return r; }
typedef float f32x2 __attribute__((ext_vector_type(2)));

typedef unsigned u32x2 __attribute__((ext_vector_type(2)));
typedef _Float16 f16x2 __attribute__((ext_vector_type(2)));
__device__ __forceinline__ unsigned pk_f16(float a, float b) { f16x2 v; v.x = (_Float16)a; v.y = (_Float16)b; return __builtin_bit_cast(unsigned, v); }
__device__ __forceinline__ float bf_lo(unsigned w) { return __uint_as_float(w << 16); }
__device__ __forceinline__ float bf_hi(unsigned w) { return __uint_as_float(w & 0xffff0000u); }
template <class V> __device__ __forceinline__ void st_nt(V* p, V v) { __builtin_nontemporal_store(v, p); }
__device__ __forceinline__ float sigm(float z) { return __builtin_amdgcn_rcpf(1.0f + __builtin_amdgcn_exp2f(-1.4426950409f * z)); }
__device__ __forceinline__ f32x2 exp2n2(f32x2 z) { const f32x2 t = z * (-1.4426950409f); f32x2 e; e.x = __builtin_amdgcn_exp2f(t.x); e.y = __builtin_amdgcn_exp2f(t.y); return e; }
__device__ __forceinline__ f32x2 rcp2(f32x2 d) { f32x2 r; r.x = __builtin_amdgcn_rcpf(d.x); r.y = __builtin_amdgcn_rcpf(d.y); return r; }
__device__ __forceinline__ f32x2 sigm2(f32x2 z) { return rcp2(exp2n2(z) + 1.0f); }
__device__ __forceinline__ f32x4 sigm4(f32x4 z) { const f32x2 lo = sigm2(__builtin_shufflevector(z, z, 0, 1)), hi = sigm2(__builtin_shufflevector(z, z, 2, 3)); return (f32x4){lo.x, lo.y, hi.x, hi.y}; }

struct EpiIn {
    static constexpr bool PERM = true, AFTER_DRAIN = false, HAS_MID = false; static constexpr int AUX_A = 0;
    bf16_t *Q, *KK, *V, *GS, *U, *GA, *GB; bf16_t* LF; const float* LB;
    __device__ __forceinline__ void operator()(const f32x4 (&acc)[2][2][4][2], const Unit& u, int wr, int wc, int fr, int fq) const {
        const int row0 = u.pm * BM + wr * 64 + fr; const int type = u.pn >> 2;
        if (type >= 6) {
            const int col = 128 * (u.pn - 24) + wc * 32 + 8 * fq;
#pragma unroll
            for (int ai = 0; ai < 2; ++ai)
#pragma unroll
                for (int m = 0; m < 4; ++m) { const size_t off = (size_t)(row0 + ai * HALF + m * 16) * 1024 + col; float rr[8], gb[8];
#pragma unroll
                    for (int n = 0; n < 2; ++n)
#pragma unroll
                        for (int j = 0; j < 4; j += 2) { const f32x4 za = acc[ai][0][m][n], zb = acc[ai][1][m][n];
                            const f32x2 da = exp2n2((f32x2){za[j], za[j + 1]}) + 1.0f, db = exp2n2((f32x2){zb[j], zb[j + 1]}) + 1.0f;
                            const f32x2 r2 = db * rcp2(da), g2 = rcp2(db);
                            rr[4 * n + j] = r2.x; rr[4 * n + j + 1] = r2.y; gb[4 * n + j] = g2.x; gb[4 * n + j + 1] = g2.y; }
                    u32x4 wr_, wg; wr_.x = cvt_pk_bf16(rr[0], rr[1]); wr_.y = cvt_pk_bf16(rr[2], rr[3]); wr_.z = cvt_pk_bf16(rr[4], rr[5]); wr_.w = cvt_pk_bf16(rr[6], rr[7]);
                    wg.x = cvt_pk_bf16(gb[0], gb[1]); wg.y = cvt_pk_bf16(gb[2], gb[3]); wg.z = cvt_pk_bf16(gb[4], gb[5]); wg.w = cvt_pk_bf16(gb[6], gb[7]);
                    st_nt((u32x4*)(GA + off), wr_); st_nt((u32x4*)(GB + off), wg); }
        } else if (type == 3 || type == 5) {
            const int col = 128 * (type == 3 ? u.pn - 12 : u.pn - 16) + wc * 32 + 8 * fq;
#pragma unroll
            for (int ai = 0; ai < 2; ++ai)
#pragma unroll
                for (int m = 0; m < 4; ++m) { bf16_t* rowp = U + (size_t)(row0 + ai * HALF + m * 16) * 1024 + col;
                    const f32x4 a0 = acc[ai][0][m][0], a1 = acc[ai][0][m][1], b0 = acc[ai][1][m][0], b1 = acc[ai][1][m][1];
                    const f32x4 u0 = a0 * sigm4(b0), u1 = a1 * sigm4(b1);
                    u32x4 w; w.x = cvt_pk_bf16(u0[0], u0[1]); w.y = cvt_pk_bf16(u0[2], u0[3]); w.z = cvt_pk_bf16(u1[0], u1[1]); w.w = cvt_pk_bf16(u1[2], u1[3]);
                    st_nt((u32x4*)rowp, w); }
        } else if (type == 2) {
            const int col0 = (u.pn & 3) * 256 + wc * 32 + 8 * fq;
#pragma unroll
            for (int ai = 0; ai < 2; ++ai)
#pragma unroll
                for (int m = 0; m < 4; ++m) { bf16_t* rowp = LF + (size_t)(row0 + ai * HALF + m * 16) * 1024 + col0;
#pragma unroll
                    for (int bj = 0; bj < 2; ++bj) { const f32x4 z0 = acc[ai][bj][m][0], z1 = acc[ai][bj][m][1];
                        const f32x4 s0 = sigm4(z0), s1 = sigm4(z1); u32x4 w; w.x = pk_f16(s0[0], s0[1]); w.y = pk_f16(s0[2], s0[3]); w.z = pk_f16(s1[0], s1[1]); w.w = pk_f16(s1[2], s1[3]);
                        st_nt((u32x4*)(rowp + bj * HALF), w); } }
        } else if (type == 0) plain<1>(acc, Q, u, row0, wc, fq);
        else if (type == 4) plain<0>(acc, V, u, row0, wc, fq);
        else plain<1>(acc, GS, u, row0, wc, fq);
    }
    template <int MODE  > static __device__ __forceinline__ void plain(const f32x4 (&acc)[2][2][4][2], bf16_t* dst, const Unit& u, int row0, int wc, int fq) {
        const int col0 = (u.pn & 3) * 256 + wc * 32 + 8 * fq;
#pragma unroll
        for (int ai = 0; ai < 2; ++ai)
#pragma unroll
            for (int m = 0; m < 4; ++m) { bf16_t* rowp = dst + (size_t)(row0 + ai * HALF + m * 16) * 1024 + col0;
#pragma unroll
                for (int bj = 0; bj < 2; ++bj) { f32x4 v0 = acc[ai][bj][m][0], v1 = acc[ai][bj][m][1];
                    if (MODE == 1) { v0 = v0 * sigm4(v0); v1 = v1 * sigm4(v1); }
                    u32x4 w; w.x = cvt_pk_bf16(v0[0], v0[1]); w.y = cvt_pk_bf16(v0[2], v0[3]); w.z = cvt_pk_bf16(v1[0], v1[1]); w.w = cvt_pk_bf16(v1[2], v1[3]);
                    st_nt((u32x4*)(rowp + bj * HALF), w); } }
    }
};

struct EpiMerge {
    static constexpr bool PERM = true, AFTER_DRAIN = false, HAS_MID = true; static constexpr int AUX_A = 0;
    bf16_t* MG; const bf16_t *RT, *GB;
    __device__ __forceinline__ void mid(f32x4 (&acc)[2][2][4][2], const Unit& u, int wr, int wc, int fr, int fq) const {
        int row0 = u.pm * BM + wr * 64 + fr; asm volatile("" : "+v"(row0));
        const int col0 = u.pn * 256 + wc * 32 + 8 * fq;
#pragma unroll
        for (int ai = 0; ai < 2; ++ai)
#pragma unroll
            for (int m = 0; m < 4; ++m) { const size_t off = (size_t)(row0 + ai * HALF + m * 16) * 1024 + col0;
#pragma unroll
                for (int bj = 0; bj < 2; ++bj) { const u32x4 g = *(const u32x4*)(RT + off + bj * HALF); f32x4 v0 = acc[ai][bj][m][0], v1 = acc[ai][bj][m][1];
                    v0[0] *= bf_lo(g.x); v0[1] *= bf_hi(g.x); v0[2] *= bf_lo(g.y); v0[3] *= bf_hi(g.y); v1[0] *= bf_lo(g.z); v1[1] *= bf_hi(g.z); v1[2] *= bf_lo(g.w); v1[3] *= bf_hi(g.w);
                    acc[ai][bj][m][0] = v0; acc[ai][bj][m][1] = v1; }
                if (m == 3) asm volatile("" ::: "memory"); }
    }
    __device__ __forceinline__ void operator()(const f32x4 (&acc)[2][2][4][2], const Unit& u, int wr, int wc, int fr, int fq) const {
        const int row0 = u.pm * BM + wr * 64 + fr; const int col0 = u.pn * 256 + wc * 32 + 8 * fq;
#pragma unroll
        for (int ai = 0; ai < 2; ++ai) {
            u32x4 gq[4][2];
#pragma unroll
            for (int m = 0; m < 4; ++m)
#pragma unroll
                for (int bj = 0; bj < 2; ++bj) gq[m][bj] = *(const u32x4*)(GB + (size_t)(row0 + ai * HALF + m * 16) * 1024 + col0 + bj * HALF);
#pragma unroll
            for (int m = 0; m < 4; ++m) { const size_t off = (size_t)(row0 + ai * HALF + m * 16) * 1024 + col0;
#pragma unroll
                for (int bj = 0; bj < 2; ++bj) { const u32x4 g = gq[m][bj]; f32x4 v0 = acc[ai][bj][m][0], v1 = acc[ai][bj][m][1];
                    v0[0] *= bf_lo(g.x); v0[1] *= bf_hi(g.x); v0[2] *= bf_lo(g.y); v0[3] *= bf_hi(g.y); v1[0] *= bf_lo(g.z); v1[1] *= bf_hi(g.z); v1[2] *= bf_lo(g.w); v1[3] *= bf_hi(g.w);
                    u32x4 w; w.x = cvt_pk_bf16(v0[0], v0[1]); w.y = cvt_pk_bf16(v0[2], v0[3]); w.z = cvt_pk_bf16(v1[0], v1[1]); w.w = cvt_pk_bf16(v1[2], v1[3]);
                    *(u32x4*)(MG + off + bj * HALF) = w; } } }
    }
};

struct EpiX1 {
    static constexpr bool PERM = true, AFTER_DRAIN = false, HAS_MID = false; static constexpr int AUX_A = 0;
    const bf16_t* H; const float* RINV; const float* G1; bf16_t* XB; float* SS;
    __device__ __forceinline__ void operator()(const f32x4 (&acc)[2][2][4][2], const Unit& u, int wr, int wc, int fr, int fq) const {
        const int row0 = u.pm * BM + wr * 64 + fr, col0 = u.pn * BM + wc * 32 + 8 * fq;
        f32x4 gi[2][2];
#pragma unroll
        for (int bj = 0; bj < 2; ++bj)
#pragma unroll
            for (int n = 0; n < 2; ++n) { const f32x4 g = *(const f32x4*)(G1 + col0 + bj * HALF + n * 4);
                gi[bj][n] = (f32x4){__builtin_amdgcn_rcpf(g[0]), __builtin_amdgcn_rcpf(g[1]), __builtin_amdgcn_rcpf(g[2]), __builtin_amdgcn_rcpf(g[3])}; }
#pragma unroll
        for (int ai = 0; ai < 2; ++ai) {
            u32x4 xq[4][2]; float ri[4];
#pragma unroll
            for (int m = 0; m < 4; ++m) { ri[m] = RINV[row0 + ai * HALF + m * 16];
#pragma unroll
                for (int bj = 0; bj < 2; ++bj) xq[m][bj] = *(const u32x4*)(H + (size_t)(row0 + ai * HALF + m * 16) * 1024 + col0 + bj * HALF); }
#pragma unroll
            for (int m = 0; m < 4; ++m) { const int row = row0 + ai * HALF + m * 16; const size_t off = (size_t)row * 1024 + col0; float q = 0.f;
#pragma unroll
                for (int bj = 0; bj < 2; ++bj) { const u32x4 hb = xq[m][bj];
                    const f32x4 v0 = (f32x4){bf_lo(hb.x), bf_hi(hb.x), bf_lo(hb.y), bf_hi(hb.y)} * ri[m] * gi[bj][0] + acc[ai][bj][m][0];
                    const f32x4 v1 = (f32x4){bf_lo(hb.z), bf_hi(hb.z), bf_lo(hb.w), bf_hi(hb.w)} * ri[m] * gi[bj][1] + acc[ai][bj][m][1];
                    q += ((v0[0] * v0[0] + v0[1] * v0[1]) + (v0[2] * v0[2] + v0[3] * v0[3])) + ((v1[0] * v1[0] + v1[1] * v1[1]) + (v1[2] * v1[2] + v1[3] * v1[3]));
                    u32x4 w; w.x = cvt_pk_bf16(v0[0], v0[1]); w.y = cvt_pk_bf16(v0[2], v0[3]); w.z = cvt_pk_bf16(v1[0], v1[1]); w.w = cvt_pk_bf16(v1[2], v1[3]);
                    *(u32x4*)(XB + off + bj * HALF) = w; }
                q += __shfl_xor(q, 16); q += __shfl_xor(q, 32);
                if (fq == 0) SS[(size_t)row * 16 + u.pn * 4 + wc] = q; } }
    }
};
struct EpiZZ {
    static constexpr bool PERM = true, AFTER_DRAIN = false, HAS_MID = false; static constexpr int AUX_A = 0;
    bf16_t* ZZ; const float* SS;
    __device__ __forceinline__ void operator()(const f32x4 (&acc)[2][2][4][2], const Unit& u, int wr, int wc, int fr, int fq) const {
        const int row0 = u.pm * BM + wr * 64 + fr, col0 = u.pn * BM + wc * 32 + 8 * fq;
        float r2v[2][4];
        { f32x4 pq[2][4];
#pragma unroll
          for (int ai = 0; ai < 2; ++ai)
#pragma unroll
              for (int m = 0; m < 4; ++m) pq[ai][m] = *(const f32x4*)(SS + (size_t)(row0 + ai * HALF + m * 16) * 16 + 4 * fq);
#pragma unroll
          for (int ai = 0; ai < 2; ++ai)
#pragma unroll
              for (int m = 0; m < 4; ++m) { const f32x4 p = pq[ai][m]; float s = (p[0] + p[1]) + (p[2] + p[3]); s += __shfl_xor(s, 16); s += __shfl_xor(s, 32);
                  r2v[ai][m] = __builtin_amdgcn_rcpf(s * (1.0f / 1024.0f) + 1e-6f); } }
#pragma unroll
        for (int ai = 0; ai < 2; ++ai)
#pragma unroll
            for (int m = 0; m < 4; ++m) { const int row = row0 + ai * HALF + m * 16;
                const float r2 = r2v[ai][m];
                bf16_t* rowp = ZZ + (size_t)row * 4096 + col0;
#pragma unroll
                for (int bj = 0; bj < 2; ++bj) { f32x4 v0 = acc[ai][bj][m][0], v1 = acc[ai][bj][m][1];
#pragma unroll
                    for (int j = 0; j < 4; ++j) { const float a = fmaxf(v0[j], 0.f), b = fmaxf(v1[j], 0.f); v0[j] = a * a * r2; v1[j] = b * b * r2; }
                    u32x4 w; w.x = cvt_pk_bf16(v0[0], v0[1]); w.y = cvt_pk_bf16(v0[2], v0[3]); w.z = cvt_pk_bf16(v1[0], v1[1]); w.w = cvt_pk_bf16(v1[2], v1[3]);
                    st_nt((u32x4*)(rowp + bj * HALF), w); } }
    }
};
struct EpiX2 {
    static constexpr bool PERM = false, AFTER_DRAIN = false, HAS_MID = false; static constexpr int AUX_A = 0;
    const bf16_t* XB; float* OUT; const float* GF; float* SS2; unsigned* CNT;
    __device__ __forceinline__ void operator()(const f32x4 (&acc_)[2][2][4][2], const Unit& u, int wr, int wc, int fr, int fq) const {
        f32x4 (&acc)[2][2][4][2] = const_cast<f32x4 (&)[2][2][4][2]>(acc_);
        const int row0 = u.pm * BM + wr * 64 + fr, col0 = u.pn * BM + wc * 32 + 4 * fq;
#pragma unroll
        for (int ai = 0; ai < 2; ++ai) {
            u32x2 xq[4][2][2];
#pragma unroll
            for (int m = 0; m < 4; ++m)
#pragma unroll
                for (int bj = 0; bj < 2; ++bj)
#pragma unroll
                    for (int n = 0; n < 2; ++n) xq[m][bj][n] = *(const u32x2*)(XB + (size_t)(row0 + ai * HALF + m * 16) * 1024 + col0 + bj * HALF + n * 16);
#pragma unroll
            for (int m = 0; m < 4; ++m) { const int row = row0 + ai * HALF + m * 16; float q = 0.f;
#pragma unroll
                for (int bj = 0; bj < 2; ++bj)
#pragma unroll
                    for (int n = 0; n < 2; ++n) { const u32x2 xb = xq[m][bj][n]; f32x4 v = acc[ai][bj][m][n];
                        v[0] += bf_lo(xb.x); v[1] += bf_hi(xb.x); v[2] += bf_lo(xb.y); v[3] += bf_hi(xb.y); acc[ai][bj][m][n] = v;
                        q += (v[0] * v[0] + v[1] * v[1]) + (v[2] * v[2] + v[3] * v[3]); }
                q += __shfl_xor(q, 16); q += __shfl_xor(q, 32);
                if (fq == 0) (void)__hip_atomic_fetch_add(SS2 + row, q, __ATOMIC_RELAXED, __HIP_MEMORY_SCOPE_AGENT); } }
        asm volatile("s_waitcnt vmcnt(0)" ::: "memory");
        unsigned* cnt = CNT + 64 * u.pm;
        if ((threadIdx.x & 63) == 0) (void)__hip_atomic_fetch_add(cnt, 1u, __ATOMIC_RELAXED, __HIP_MEMORY_SCOPE_AGENT);
        { unsigned sp = 0; while ((unsigned)__builtin_amdgcn_readfirstlane(__hip_atomic_load(cnt, __ATOMIC_RELAXED, __HIP_MEMORY_SCOPE_AGENT)) < 32u) { __builtin_amdgcn_s_sleep(2); if (++sp > (1u << 22)) break; } }
        __builtin_amdgcn_fence(__ATOMIC_ACQUIRE, "agent");
        f32x4 gv[2][2];
#pragma unroll
        for (int bj = 0; bj < 2; ++bj)
#pragma unroll
            for (int n = 0; n < 2; ++n) gv[bj][n] = *(const f32x4*)(GF + col0 + bj * HALF + n * 16);
        float sv[2][4];
#pragma unroll
        for (int ai = 0; ai < 2; ++ai)
#pragma unroll
            for (int m = 0; m < 4; ++m) sv[ai][m] = __hip_atomic_load(SS2 + row0 + ai * HALF + m * 16, __ATOMIC_RELAXED, __HIP_MEMORY_SCOPE_AGENT);
#pragma unroll
        for (int ai = 0; ai < 2; ++ai)
#pragma unroll
            for (int m = 0; m < 4; ++m) { const int row = row0 + ai * HALF + m * 16; float* rowp = OUT + (size_t)row * 1024 + col0;
                const float s = sv[ai][m]; const float rstd = 1.0f / sqrtf(s * (1.0f / 1024.0f) + 1e-6f);
#pragma unroll
                for (int bj = 0; bj < 2; ++bj)
#pragma unroll
                    for (int n = 0; n < 2; ++n) st_nt((f32x4*)(rowp + bj * HALF + n * 16), acc[ai][bj][m][n] * rstd * gv[bj][n]); }
    }
};

struct EpiDry {
    static constexpr bool PERM = true, AFTER_DRAIN = false, HAS_MID = false; static constexpr int AUX_A = 0;
    float* SINK;
    __device__ __forceinline__ void operator()(const f32x4 (&acc)[2][2][4][2], const Unit& u, int wr, int wc, int fr, int fq) const {
        f32x4 s = (f32x4){0.f, 0.f, 0.f, 0.f};
#pragma unroll
        for (int ai = 0; ai < 2; ++ai)
#pragma unroll
            for (int bj = 0; bj < 2; ++bj)
#pragma unroll
                for (int m = 0; m < 4; ++m)
#pragma unroll
                    for (int n = 0; n < 2; ++n) s += acc[ai][bj][m][n];
        if (s[0] + s[1] + s[2] + s[3] == 1.2345e33f) SINK[0] = s[0];
    }
};
template <class Epi, class Sched, bool ALIGN_EPI = false, bool SP2 = false>
__device__ __forceinline__ void gemm_phase(PG8_LAS unsigned char* lds, const Gemm g, const Sched& S, const Epi& E) {
    const int tid = threadIdx.x, wid = __builtin_amdgcn_readfirstlane(tid >> 6), lane = tid & 63, wr = wid >> 2, wc = wid & 3, fr = lane & 15, fq = lane >> 4;
    const int K = g.K, nt = K / BK, LD = g.ld ? g.ld : g.K, skt = g.split_kt ? g.split_kt : (1 << 30);
    unsigned voffA[2], voffB[2];
#pragma unroll
    for (int i = 0; i < 2; ++i) { int R, C; stage_rc(tid * 16 + i * 8192, R, C); const int Rb = Epi::PERM ? ((R & ~31) + perm32(R & 31)) : R;
        voffA[i] = (unsigned)(R * LD + C) * 2u; voffB[i] = (unsigned)(Rb * LD + C) * 2u; }
    const size_t kstep = (size_t)(BK * 2);
    const long adjA = g.splitA - (long)g.split_kt * (BK * 2), adjB = g.splitB - (long)g.split_kt * (BK * 2);
    const size_t hstep = (size_t)HALF * LD * 2;
    const size_t tstep = 2 * hstep;
    const unsigned ldsw = (unsigned)wid * 1024u;
    const int aoff = lds_byte(wr * 64 + fr, fq * 8), boff = lds_byte(wc * 32 + fr, fq * 8);
#define PG8_SA(b, h) (((b) * 2 + (h)) * HTB)
#define PG8_SB(b, h) ((4 + (b) * 2 + (h)) * HTB)
#define PG8_STAGE(bufoff, gbase, voff) do { _Pragma("unroll") for (int _i = 0; _i < 2; ++_i) \
        __builtin_amdgcn_global_load_lds((const unsigned*)((const char*)(gbase) + (voff)[_i]), (PG8_LAS unsigned*)(lds + (bufoff) + ldsw + _i * 8192), 16, 0, 0); } while (0)
#define PG8_LDA(dst, b, h) do { _Pragma("unroll") for (int m = 0; m < 4; ++m) _Pragma("unroll") for (int k = 0; k < 2; ++k) dst[m][k] = *(const PG8_LAS bf16x8*)(lds + PG8_SA(b, h) + aoff + m * 2048 + k * 1024); } while (0)
#define PG8_LDB(dst, b, h) do { _Pragma("unroll") for (int n = 0; n < 2; ++n) _Pragma("unroll") for (int k = 0; k < 2; ++k) dst[n][k] = *(const PG8_LAS bf16x8*)(lds + PG8_SB(b, h) + boff + n * 2048 + k * 1024); } while (0)
#define PG8_MMA(ai, bj, At, Bt) do { __builtin_amdgcn_s_setprio(1); _Pragma("unroll") for (int m = 0; m < 4; ++m) _Pragma("unroll") for (int n = 0; n < 2; ++n) _Pragma("unroll") for (int k = 0; k < 2; ++k) \
        acc[ai][bj][m][n] = __builtin_amdgcn_mfma_f32_16x16x32_bf16(Bt[n][k], At[m][k], acc[ai][bj][m][n], 0, 0, 0); __builtin_amdgcn_s_setprio(0); } while (0)
#define PG8_WAIT_V(n) asm volatile("s_waitcnt vmcnt(" #n ")" ::: "memory")
#define PG8_WAIT_L(n) asm volatile("s_waitcnt lgkmcnt(" #n ")" ::: "memory")
#define PG8_BAR __builtin_amdgcn_s_barrier()
#define PG8_SCHED __builtin_amdgcn_sched_barrier(0)
    Unit cur, nxt; int ui = 0;
    if (!S.next(0, cur)) return;
    f32x4 acc[2][2][4][2];
#pragma unroll
    for (int a = 0; a < 2; ++a)
#pragma unroll
        for (int b = 0; b < 2; ++b)
#pragma unroll
            for (int m = 0; m < 4; ++m)
#pragma unroll
                for (int n = 0; n < 2; ++n) acc[a][b][m][n] = (f32x4){0.f, 0.f, 0.f, 0.f};
    bf16x8 At[4][2], B0[2][2], B1[2][2];
    const char* cA = (const char*)g.A + (size_t)cur.pm * tstep; const char* cB = (const char*)g.Bt + (size_t)cur.pn * tstep;
    S.a_ready(cur);
    if constexpr (SP2) {
        PG8_STAGE(PG8_SB(0, 0), cB, voffB); PG8_STAGE(PG8_SB(0, 1), cB + hstep, voffB); PG8_STAGE(PG8_SA(0, 0), cA, voffA); PG8_STAGE(PG8_SA(0, 1), cA + hstep, voffA);
        if (wr == 1) PG8_BAR;
        PG8_WAIT_V(2); PG8_BAR;
        PG8_STAGE(PG8_SB(1, 0), cB + kstep, voffB); PG8_STAGE(PG8_SA(1, 0), cA + kstep, voffA); PG8_STAGE(PG8_SB(1, 1), cB + hstep + kstep, voffB);
        PG8_WAIT_V(6); PG8_BAR;
    } else {
        PG8_STAGE(PG8_SB(0, 0), cB, voffB); PG8_STAGE(PG8_SA(0, 0), cA, voffA); PG8_STAGE(PG8_SB(0, 1), cB + hstep, voffB); PG8_STAGE(PG8_SA(0, 1), cA + hstep, voffA);
        if (wr == 1) PG8_BAR;
        PG8_WAIT_V(4); PG8_BAR;
        PG8_STAGE(PG8_SB(1, 0), cB + kstep, voffB); PG8_STAGE(PG8_SA(1, 0), cA + kstep, voffA); PG8_STAGE(PG8_SB(1, 1), cB + hstep + kstep, voffB);
        PG8_WAIT_V(6); PG8_BAR;
    }
    for (;;) {
        const bool has_next = S.next(ui + 1, nxt);
        const char* nA = has_next ? (const char*)g.A + (size_t)nxt.pm * tstep : cA; const char* nB = has_next ? (const char*)g.Bt + (size_t)nxt.pn * tstep : cB;
        for (int t = 0; t < nt; t += 2) {
            const bool last = (t == nt - 2);
            const char* a1 = cA + (size_t)(t + 1) * kstep + (t + 1 >= skt ? adjA : 0);
            const char* a2 = last ? nA : cA + (size_t)(t + 2) * kstep + (t + 2 >= skt ? adjA : 0); const char* b2 = last ? nB : cB + (size_t)(t + 2) * kstep + (t + 2 >= skt ? adjB : 0);
            if constexpr (Epi::HAS_MID) { if (t == skt) E.mid(acc, cur, wr, wc, fr, fq); }
            const char* a3 = a2 + kstep; const char* b3 = b2 + kstep;
            if (last && has_next) S.a_ready(nxt);
            if constexpr (SP2) {
            PG8_LDB(B0, 0, 0); PG8_LDB(B1, 0, 1); PG8_SCHED; PG8_LDA(At, 0, 0); PG8_STAGE(PG8_SA(1, 1), a1 + hstep, voffA);
            PG8_WAIT_V(8); PG8_WAIT_L(0); PG8_BAR; PG8_MMA(0, 0, At, B0); PG8_MMA(0, 1, At, B1); PG8_BAR; PG8_SCHED;
            PG8_LDA(At, 0, 1); PG8_STAGE(PG8_SB(0, 0), b2, voffB); PG8_STAGE(PG8_SB(0, 1), b2 + hstep, voffB); PG8_STAGE(PG8_SA(0, 0), a2, voffA);
            PG8_WAIT_V(8); PG8_WAIT_L(0); PG8_BAR; PG8_MMA(1, 0, At, B0); PG8_MMA(1, 1, At, B1); PG8_BAR; PG8_SCHED;
            PG8_LDB(B0, 1, 0); PG8_LDB(B1, 1, 1); PG8_SCHED; PG8_LDA(At, 1, 0); PG8_STAGE(PG8_SA(0, 1), a2 + hstep, voffA);
            PG8_WAIT_V(8); PG8_WAIT_L(0); PG8_BAR; PG8_MMA(0, 0, At, B0); PG8_MMA(0, 1, At, B1); PG8_BAR; PG8_SCHED;
            PG8_LDA(At, 1, 1); PG8_STAGE(PG8_SB(1, 0), b3, voffB); PG8_STAGE(PG8_SB(1, 1), b3 + hstep, voffB); PG8_STAGE(PG8_SA(1, 0), a3, voffA);
            PG8_WAIT_V(8); PG8_WAIT_L(0); PG8_BAR; PG8_MMA(1, 0, At, B0); PG8_MMA(1, 1, At, B1); PG8_BAR; PG8_SCHED;
            } else {
            PG8_LDB(B0, 0, 0); PG8_SCHED; PG8_LDA(At, 0, 0); PG8_STAGE(PG8_SA(1, 1), a1 + hstep, voffA);
            PG8_WAIT_L(8); PG8_BAR; PG8_WAIT_L(0); PG8_MMA(0, 0, At, B0); PG8_BAR; PG8_SCHED;
            PG8_LDB(B1, 0, 1); PG8_STAGE(PG8_SB(0, 0), b2, voffB);
            PG8_BAR; PG8_WAIT_L(0); PG8_MMA(0, 1, At, B1); PG8_BAR;
            PG8_LDA(At, 0, 1); PG8_STAGE(PG8_SA(0, 0), a2, voffA);
            PG8_BAR; PG8_WAIT_L(0); PG8_MMA(1, 0, At, B0); PG8_BAR; PG8_SCHED;
            PG8_STAGE(PG8_SB(0, 1), b2 + hstep, voffB);
            PG8_WAIT_V(6); PG8_BAR; PG8_MMA(1, 1, At, B1); PG8_BAR;
            PG8_LDB(B0, 1, 0); PG8_SCHED; PG8_LDA(At, 1, 0); PG8_STAGE(PG8_SA(0, 1), a2 + hstep, voffA);
            PG8_WAIT_L(8); PG8_BAR; PG8_WAIT_L(0); PG8_MMA(0, 0, At, B0); PG8_BAR; PG8_SCHED;
            PG8_LDB(B1, 1, 1); PG8_STAGE(PG8_SB(1, 0), b3, voffB);
            PG8_BAR; PG8_WAIT_L(0); PG8_MMA(0, 1, At, B1); PG8_BAR;
            PG8_LDA(At, 1, 1); PG8_STAGE(PG8_SA(1, 0), a3, voffA);
            PG8_BAR; PG8_WAIT_L(0); PG8_MMA(1, 0, At, B0); PG8_BAR; PG8_SCHED;
            PG8_STAGE(PG8_SB(1, 1), b3 + hstep, voffB);
            PG8_WAIT_V(6); PG8_BAR; PG8_MMA(1, 1, At, B1); PG8_BAR;
            }
        }
        if constexpr (ALIGN_EPI) { if (wr == 0) PG8_BAR; }
        if constexpr (!Epi::AFTER_DRAIN) { E(acc, cur, wr, wc, fr, fq); S.done(cur); }
        if (!has_next) break;
#pragma unroll
        for (int a = 0; a < 2; ++a)
#pragma unroll
            for (int b = 0; b < 2; ++b)
#pragma unroll
                for (int m = 0; m < 4; ++m)
#pragma unroll
                    for (int n = 0; n < 2; ++n) acc[a][b][m][n] = (f32x4){0.f, 0.f, 0.f, 0.f};
        cur = nxt; cA = nA; cB = nB; ++ui;
        if constexpr (ALIGN_EPI) { if (wr == 1) PG8_BAR; }
    }
    PG8_WAIT_V(0);
    if constexpr (!ALIGN_EPI) { if (wr == 0) PG8_BAR; }
    PG8_BAR;
    if constexpr (Epi::AFTER_DRAIN) { E.fused(acc, cur, wr, wc, fr, fq, lds, wid, lane); S.done(cur); }
#undef PG8_SA
#undef PG8_SB
#undef PG8_STAGE
#undef PG8_LDA
#undef PG8_LDB
#undef PG8_MMA
#undef PG8_WAIT_V
#undef PG8_WAIT_L
#undef PG8_BAR
#undef PG8_SCHED
}
}

#ifndef MK_N_LAUNCHES
#define MK_N_LAUNCHES 1
#endif
namespace cg = cooperative_groups;
#define LAS __attribute__((address_space(3)))
#define DI __device__ __forceinline__
typedef unsigned short bf16;
typedef float f32x4 __attribute__((ext_vector_type(4)));
typedef float f32x2 __attribute__((ext_vector_type(2)));
typedef short bf16x8 __attribute__((ext_vector_type(8)));
typedef unsigned u32x4 __attribute__((ext_vector_type(4)));
typedef unsigned u32x2 __attribute__((ext_vector_type(2)));

constexpr int T = 32768, D = 1024, SEQ = 8192, DIN = 8192, FF = 4096;
constexpr float EPS = 1e-6f;
constexpr int NPHASES = 8;
constexpr int LDS_MISC = 131072;
constexpr int LDS_BYTES = 139264;

constexpr size_t MiB = 1u << 20;
constexpr size_t WS_WIN = 0;
constexpr size_t WS_L   = 0;
constexpr size_t WS_WA  = 16 * MiB;
constexpr size_t WS_WB  = 18 * MiB;
constexpr size_t WS_WO  = 20 * MiB;
constexpr size_t WS_WMI = 22 * MiB;
constexpr size_t WS_WMO = 30 * MiB;
constexpr size_t WS_SS  = 38 * MiB;
constexpr size_t WS_LB  = 40 * MiB;
constexpr size_t WS_DSEG = 40 * MiB + 65536;
constexpr size_t WS_CTL = 41 * MiB, CTL_CNT = 16384, CTL_SS2 = 65536, CTL_BYTES = 196608;
constexpr size_t WS_RINV = 42 * MiB;
constexpr size_t WS_END = 512 * MiB;
constexpr size_t SLOT = 64 * MiB;
constexpr size_t S_V = 1 * SLOT, S_U = 2 * SLOT, S_H = 3 * SLOT, S_LF = 4 * SLOT, S_GS = 5 * SLOT, S_GA = 6 * SLOT, S_GB = 7 * SLOT;
constexpr size_t S_X1B = S_V, S_OA = S_U, S_UB = S_H, S_MG = S_LF, S_ZZ = 2 * SLOT;

struct Args { const float* in[16]; float* out; unsigned char* ws; int ph_lo, ph_hi, sync_mode, pad; };

DI float wave_sum(float v) {
#pragma unroll
    for (int o = 1; o < 64; o <<= 1) v += __shfl_xor(v, o);
    return v;
}
DI unsigned f2bf(float f) { unsigned u = __builtin_bit_cast(unsigned, f); return (u + 0x7fffu + ((u >> 16) & 1u)) >> 16; }
typedef __bf16 bf16x2_t __attribute__((ext_vector_type(2)));
DI unsigned pk2(float lo, float hi) { f32x2 v = {lo, hi}; bf16x2_t b = __builtin_convertvector(v, bf16x2_t); return __builtin_bit_cast(unsigned, b); }
DI float bflo(unsigned w) { return __uint_as_float(w << 16); }
DI float bfhi(unsigned w) { return __uint_as_float(w & 0xffff0000u); }
DI float ex2(float x) { return __builtin_amdgcn_exp2f(x); }

DI void p0_transpose_item(const float* W, int K, int N, bf16* WT, int k0, int n0, int src_n0, const float* kscale, LAS float* scr, int lane) {
    float wv[32];
#pragma unroll
    for (int i = 0; i < 32; ++i) wv[i] = __builtin_nontemporal_load(W + (size_t)(k0 + 2 * i + (lane >> 5)) * N + src_n0 + (lane & 31));
#pragma unroll
    for (int i = 0; i < 32; ++i) { const int kk = 2 * i + (lane >> 5); float v = wv[i]; if (kscale) v *= kscale[k0 + kk]; scr[kk * 33 + (lane & 31)] = v; }
    asm volatile("s_waitcnt lgkmcnt(0)" ::: "memory");
    const int c = lane & 7;
#pragma unroll
    for (int j = 0; j < 4; ++j) { const int n = (lane >> 3) + 8 * j; const LAS float* s = scr + (8 * c) * 33 + n;
        u32x4 o; o.x = pk2(s[0 * 33], s[1 * 33]); o.y = pk2(s[2 * 33], s[3 * 33]); o.z = pk2(s[4 * 33], s[5 * 33]); o.w = pk2(s[6 * 33], s[7 * 33]);
        *(u32x4*)(WT + (size_t)(n0 + n) * K + k0 + 8 * c) = o; }
    asm volatile("s_waitcnt lgkmcnt(0)" ::: "memory");
}
DI void p0_matrix(const float* W, int K, int N, bf16* WT, const float* kscale, bool glu, LAS float* scr, int gw, int ngw, int lane) {
    const int nblk = N / 32, items = (K / 64) * nblk;
    for (int it = gw; it < items; it += ngw) { const int kb = it / nblk, nb = it % nblk; const int n0 = nb * 32; int src = n0;
        if (glu) {
            const int tile = n0 >> 8, r = n0 & 255;
            if (tile < 4) src = n0;
            else if (tile < 8) src = 3072 + (n0 - 1024);
            else if (tile < 12) src = 1024 + (n0 - 2048);
            else if (tile < 16) src = 4096 + (r >> 7) * 1024 + 128 * (tile - 12) + (r & 127);
            else if (tile < 20) src = 2048 + (n0 - 4096);
            else if (tile < 24) src = 4096 + (r >> 7) * 1024 + 128 * (tile - 20 + 4) + (r & 127);
            else src = 6144 + (r >> 7) * 1024 + 128 * (tile - 24) + (r & 127); }
        p0_transpose_item(W, K, N, WT, kb * 64, n0, src, kscale, scr, lane); }
}
DI void p0_prologue(const Args& a, LAS unsigned char* lds, int G, int tid, int lane, int wave) {
    LAS float* scr = (LAS float*)(lds + wave * 16384);
    const int gw = blockIdx.x * 8 + wave, ngw = G * 8;
    unsigned char* ws = a.ws;
    p0_matrix(a.in[2], D, DIN, (bf16*)(ws + WS_WIN), nullptr, true, scr, gw, ngw, lane);
    if (blockIdx.x == 0) { const float* lp = a.in[3]; float* LB = (float*)(ws + WS_LB);
        for (int c = tid; c < 1024; c += 512) LB[c] = 1.0f / (1.0f + __expf(lp[1024 + c] - lp[c])); }
    const float* x = a.in[0]; const float* g1 = a.in[1]; bf16* H = (bf16*)(ws + S_H);
    f32x4 gv[4];
#pragma unroll
    for (int j = 0; j < 4; ++j) gv[j] = *(const f32x4*)(g1 + 4 * lane + 256 * j);
    f32x4 nxv[4], nyv[4];
    if (gw < T) {
#pragma unroll
        for (int j = 0; j < 4; ++j) nxv[j] = __builtin_nontemporal_load((const f32x4*)(x + (size_t)gw * D) + lane + 64 * j); }
    if (gw + ngw < T) {
#pragma unroll
        for (int j = 0; j < 4; ++j) nyv[j] = __builtin_nontemporal_load((const f32x4*)(x + (size_t)(gw + ngw) * D) + lane + 64 * j); }
    for (int m = gw; m < T; m += ngw) { f32x4 v[4]; float s = 0.f;
#pragma unroll
        for (int j = 0; j < 4; ++j) { v[j] = nxv[j]; nxv[j] = nyv[j]; }
        if (m + 2 * ngw < T) {
#pragma unroll
            for (int j = 0; j < 4; ++j) nyv[j] = __builtin_nontemporal_load((const f32x4*)(x + (size_t)(m + 2 * ngw) * D) + lane + 64 * j); }
#pragma unroll
        for (int j = 0; j < 4; ++j) s += (v[j].x * v[j].x + v[j].y * v[j].y) + (v[j].z * v[j].z + v[j].w * v[j].w);
        const float rms = sqrtf(wave_sum(s) * (1.0f / D) + EPS), rstd = 1.0f / rms; if (lane == 0) ((float*)(ws + WS_RINV))[m] = rms;
        u32x2* o = (u32x2*)(H + (size_t)m * D) + lane;
#pragma unroll
        for (int j = 0; j < 4; ++j) { u32x2 w; w.x = pk2(v[j].x * rstd * gv[j].x, v[j].y * rstd * gv[j].y); w.y = pk2(v[j].z * rstd * gv[j].z, v[j].w * rstd * gv[j].w); o[64 * j] = w; } }
}

DI void late_weights(const Args& a, LAS unsigned char* lds, int G, int lane, int wave) {
    LAS float* scr = (LAS float*)(lds + wave * 16384);
    const int gw = blockIdx.x * 8 + wave, ngw = G * 8;
    unsigned char* ws = a.ws;
    p0_matrix(a.in[5], D, D, (bf16*)(ws + WS_WA), nullptr, false, scr, gw, ngw, lane);
    p0_matrix(a.in[10], D, D, (bf16*)(ws + WS_WB), nullptr, false, scr, gw, ngw, lane);
    p0_matrix(a.in[11], D, D, (bf16*)(ws + WS_WO), nullptr, false, scr, gw, ngw, lane);
    p0_matrix(a.in[13], D, FF, (bf16*)(ws + WS_WMI), a.in[12], false, scr, gw, ngw, lane);
    p0_matrix(a.in[14], FF, D, (bf16*)(ws + WS_WMO), nullptr, false, scr, gw, ngw, lane);
}

constexpr int HQ_QT = 0, HQ_KT = 17408, HQ_KDT = 34816, HQ_VT = 53248, HQ_PP = 71680, HQ_ST = 80896, HQ_TOT = 115712, HQ_DV = 119808, HQ_SSQ = 120320;
constexpr int PA = 272, PB = 144;
DI bf16x8 ldfrag(const LAS unsigned char* base, int pitch, int row0, int k0, int lane) {
    return *(const LAS bf16x8*)(base + (row0 + (lane & 15)) * pitch + (k0 + 8 * (lane >> 4)) * 2);
}
#define MFMA16(a, b, c) __builtin_amdgcn_mfma_f32_16x16x32_bf16((a), (b), (c), 0, 0, 0)

template <bool PASS2>
DI void hgrn_unit(LAS unsigned char* lds, const Args& a, int unit, int tid, int lane, int w) {
    unsigned char* ws = a.ws;
    const bf16* Qb = (const bf16*)a.out;
    const bf16* Vb = (const bf16*)(ws + S_V); const bf16* LFb = (const bf16*)(ws + S_LF); const bf16* GSb = (const bf16*)(ws + S_GS); bf16* OA = (bf16*)(ws + S_OA);
    float* Lst = (float*)(ws + WS_L); float* DSEG = (float*)(ws + WS_DSEG); const float* HG = a.in[4];
    const int bh = unit >> 3, seg = unit & 7, b = bh >> 3, h = bh & 7;
    const size_t tok0 = (size_t)b * SEQ + (size_t)seg * 1024; const int cb = h * 128;
    const int fr = lane & 15, fq = lane >> 4;
    LAS float* TOT = (LAS float*)(lds + HQ_TOT); LAS float* DV = (LAS float*)(lds + HQ_DV); LAS float* SSQ = (LAS float*)(lds + HQ_SSQ);
    f32x4 S[8];
#pragma unroll
    for (int n = 0; n < 8; ++n) S[n] = (f32x4){0.f, 0.f, 0.f, 0.f};
    float segtot0 = 0.f, segtot1 = 0.f;
    const f32x2 lbv = *(const f32x2*)((const float*)(ws + WS_LB) + cb + 2 * lane); const f32x2 omlv = (f32x2){1.0f - lbv.x, 1.0f - lbv.y};
    f32x2 gh = (f32x2){1.f, 1.f};
    if (PASS2) {
        gh = *(const f32x2*)(HG + 2 * lane);
        float Lr[32], Dr[4];
#define HG_LLOAD(ii) do { const float* Li_ = Lst + (size_t)(bh * 8 + (ii)) * 16384 + (16 * w + 4 * fq) * 128 + fr; const float* Di_ = DSEG + (bh * 8 + (ii)) * 128 + 16 * w + 4 * fq; \
            _Pragma("unroll") for (int r = 0; r < 4; ++r) Dr[r] = Di_[r]; \
            _Pragma("unroll") for (int n = 0; n < 8; ++n) _Pragma("unroll") for (int r = 0; r < 4; ++r) Lr[n * 4 + r] = Li_[r * 128 + 16 * n]; } while (0)
        if (seg > 0) HG_LLOAD(0);
        for (int i = 0; i < seg; ++i) { float Lc[32], dd[4];
#pragma unroll
            for (int r = 0; r < 4; ++r) dd[r] = ex2(Dr[r]);
#pragma unroll
            for (int k = 0; k < 32; ++k) Lc[k] = Lr[k];
            if (i + 1 < seg) HG_LLOAD(i + 1);
#pragma unroll
            for (int n = 0; n < 8; ++n)
#pragma unroll
                for (int r = 0; r < 4; ++r) S[n][r] = S[n][r] * dd[r] + Lc[n * 4 + r]; }
#undef HG_LLOAD
#pragma unroll
        for (int n = 0; n < 8; ++n) { u32x2 pk; pk.x = pk2(S[n][0], S[n][1]); pk.y = pk2(S[n][2], S[n][3]); *(LAS u32x2*)(lds + HQ_ST + (16 * n + fr) * PA + (16 * w + 4 * fq) * 2) = pk; }
    }
    unsigned nlf[8], nv[8], nq[8], ngs[8];
#define HG_LOAD(cc) do { const size_t rb_ = tok0 + (size_t)(cc) * 64 + 8 * w; _Pragma("unroll") for (int i = 0; i < 8; ++i) { const size_t off = (rb_ + i) * D + cb + 2 * lane; \
            nlf[i] = *(const unsigned*)(LFb + off); nv[i] = *(const unsigned*)(Vb + off); if (PASS2) { nq[i] = *(const unsigned*)(Qb + off); ngs[i] = *(const unsigned*)(GSb + off); } } } while (0)
    HG_LOAD(0);
    for (int c = 0; c < 16; ++c) {
        unsigned vr[8], qr[8], gsc[8];
#pragma unroll
        for (int i = 0; i < 8; ++i) { vr[i] = nv[i]; if (PASS2) { qr[i] = nq[i]; gsc[i] = ngs[i]; } }
        f32x2 pl[8], kf[8]; f32x2 run = (f32x2){1.f, 1.f};
#pragma unroll
        for (int i = 0; i < 8; ++i) { const pg8::f16x2 hv = __builtin_bit_cast(pg8::f16x2, nlf[i]); const f32x2 s2 = (f32x2){(float)hv.x, (float)hv.y};
            run = run * (lbv + omlv * s2); pl[i] = run; kf[i] = omlv - omlv * s2; }
        *(LAS f32x2*)(TOT + w * 128 + 2 * lane) = run;
        __syncthreads();
        f32x2 pre = (f32x2){1.f, 1.f}, tot = (f32x2){1.f, 1.f};
#pragma unroll
        for (int ww = 0; ww < 8; ++ww) { const f32x2 t = *(const LAS f32x2*)(TOT + ww * 128 + 2 * lane); tot = tot * t; if (ww < w) pre = pre * t; }
        segtot0 += __builtin_amdgcn_logf(tot.x); segtot1 += __builtin_amdgcn_logf(tot.y);
        unsigned kd0[4], kd1[4];
#pragma unroll
        for (int i = 0; i < 8; i += 2) {
            f32x2 kd[2];
#pragma unroll
            for (int e = 0; e < 2; ++e) { const int ii = i + e; f32x2 E = pre * pl[ii]; E.x = fmaxf(E.x, 2.4e-35f); E.y = fmaxf(E.y, 2.4e-35f);
                const f32x2 inv = (f32x2){__builtin_amdgcn_rcpf(E.x), __builtin_amdgcn_rcpf(E.y)}; const f32x2 kt = kf[ii] * inv; kd[e] = kt * tot;
                if (PASS2) { const f32x2 q2 = (f32x2){bflo(qr[ii]), bfhi(qr[ii])} * E;
                    *(LAS unsigned*)(lds + HQ_QT + (8 * w + ii) * PA + 4 * lane) = pk2(q2.x, q2.y);
                    *(LAS unsigned*)(lds + HQ_KT + (8 * w + ii) * PA + 4 * lane) = pk2(kt.x, kt.y); } }
            kd0[i >> 1] = pk2(kd[0].x, kd[1].x); kd1[i >> 1] = pk2(kd[0].y, kd[1].y); }
        *(LAS u32x4*)(lds + HQ_KDT + (2 * lane) * PB + 16 * w) = (u32x4){kd0[0], kd0[1], kd0[2], kd0[3]};
        *(LAS u32x4*)(lds + HQ_KDT + (2 * lane + 1) * PB + 16 * w) = (u32x4){kd1[0], kd1[1], kd1[2], kd1[3]};
        { u32x4 v0, v1;
          v0.x = (vr[0] & 0xffffu) | (vr[1] << 16); v0.y = (vr[2] & 0xffffu) | (vr[3] << 16); v0.z = (vr[4] & 0xffffu) | (vr[5] << 16); v0.w = (vr[6] & 0xffffu) | (vr[7] << 16);
          v1.x = (vr[0] >> 16) | (vr[1] & 0xffff0000u); v1.y = (vr[2] >> 16) | (vr[3] & 0xffff0000u); v1.z = (vr[4] >> 16) | (vr[5] & 0xffff0000u); v1.w = (vr[6] >> 16) | (vr[7] & 0xffff0000u);
          *(LAS u32x4*)(lds + HQ_VT + (2 * lane) * PB + 16 * w) = v0; *(LAS u32x4*)(lds + HQ_VT + (2 * lane + 1) * PB + 16 * w) = v1; }
        if (w == 0) *(LAS f32x2*)(DV + 2 * lane) = tot;
        __syncthreads();
        if (c < 15) HG_LOAD(c + 1);
        if (PASS2) {
            const int tt = w & 3;
#pragma unroll
            for (int e = 0; e < 2; ++e) { const int st = 2 * (w >> 2) + e; f32x4 sc = (f32x4){0.f, 0.f, 0.f, 0.f};
                if (st <= tt) {
#pragma unroll
                    for (int ks = 0; ks < 4; ++ks) sc = MFMA16(ldfrag(lds + HQ_KT, PA, 16 * st, 32 * ks, lane), ldfrag(lds + HQ_QT, PA, 16 * tt, 32 * ks, lane), sc); }
                const int t = 16 * tt + fr, s0 = 16 * st + 4 * fq;
#pragma unroll
                for (int r = 0; r < 4; ++r) if (s0 + r > t) sc[r] = 0.f;
                u32x2 pk; pk.x = pk2(sc[0], sc[1]); pk.y = pk2(sc[2], sc[3]);
                *(LAS u32x2*)(lds + HQ_PP + t * PB + s0 * 2) = pk; }
            __syncthreads();
            const int mt = w & 3; f32x4 o[4];
#pragma unroll
            for (int j = 0; j < 4; ++j) o[j] = (f32x4){0.f, 0.f, 0.f, 0.f};
#pragma unroll
            for (int ks = 0; ks < 4; ++ks) { const bf16x8 bq = ldfrag(lds + HQ_QT, PA, 16 * mt, 32 * ks, lane);
#pragma unroll
                for (int j = 0; j < 4; ++j) o[j] = MFMA16(ldfrag(lds + HQ_ST, PA, 16 * (4 * (w >> 2) + j), 32 * ks, lane), bq, o[j]); }
#pragma unroll
            for (int ks = 0; ks < 2; ++ks) { const bf16x8 bp = ldfrag(lds + HQ_PP, PB, 16 * mt, 32 * ks, lane);
#pragma unroll
                for (int j = 0; j < 4; ++j) o[j] = MFMA16(ldfrag(lds + HQ_VT, PB, 16 * (4 * (w >> 2) + j), 32 * ks, lane), bp, o[j]); }
            float q = 0.f;
#pragma unroll
            for (int j = 0; j < 4; ++j) q += (o[j][0] * o[j][0] + o[j][1] * o[j][1]) + (o[j][2] * o[j][2] + o[j][3] * o[j][3]);
            q += __shfl_xor(q, 16); q += __shfl_xor(q, 32);
            if (fq == 0) SSQ[(16 * mt + fr) * 2 + (w >> 2)] = q;
            __syncthreads();
            { const f32x2 s2 = *(const LAS f32x2*)(SSQ + (16 * mt + fr) * 2); const float rstd = 1.0f / sqrtf((s2.x + s2.y) * (1.0f / 128.0f) + EPS);
#pragma unroll
              for (int j = 0; j < 4; ++j) { u32x2 pk; pk.x = pk2(o[j][0] * rstd, o[j][1] * rstd); pk.y = pk2(o[j][2] * rstd, o[j][3] * rstd);
                  *(LAS u32x2*)(lds + HQ_KT + (16 * mt + fr) * PA + (16 * (4 * (w >> 2) + j) + 4 * fq) * 2) = pk; } }
            __syncthreads();
#pragma unroll
            for (int i = 0; i < 8; ++i) { const unsigned ot = *(const LAS unsigned*)(lds + HQ_KT + (8 * w + i) * PA + 4 * lane);
                *(unsigned*)(OA + (tok0 + (size_t)c * 64 + 8 * w + i) * D + cb + 2 * lane) = pk2(bflo(ot) * gh.x * bflo(gsc[i]), bfhi(ot) * gh.y * bfhi(gsc[i])); }
        }
        { float dd[4];
#pragma unroll
          for (int r = 0; r < 4; ++r) dd[r] = DV[16 * w + 4 * fq + r];
          const bf16x8 a0 = ldfrag(lds + HQ_KDT, PB, 16 * w, 0, lane), a1 = ldfrag(lds + HQ_KDT, PB, 16 * w, 32, lane);
#pragma unroll
          for (int n = 0; n < 8; ++n) {
#pragma unroll
              for (int r = 0; r < 4; ++r) S[n][r] *= dd[r];
              S[n] = MFMA16(a0, ldfrag(lds + HQ_VT, PB, 16 * n, 0, lane), S[n]); S[n] = MFMA16(a1, ldfrag(lds + HQ_VT, PB, 16 * n, 32, lane), S[n]); }
          if (PASS2) {
#pragma unroll
              for (int n = 0; n < 8; ++n) { u32x2 pk; pk.x = pk2(S[n][0], S[n][1]); pk.y = pk2(S[n][2], S[n][3]); *(LAS u32x2*)(lds + HQ_ST + (16 * n + fr) * PA + (16 * w + 4 * fq) * 2) = pk; } }
        }
    }
    if (!PASS2) { float* Lu = Lst + (size_t)unit * 16384;
#pragma unroll
        for (int n = 0; n < 8; ++n)
#pragma unroll
            for (int r = 0; r < 4; ++r) Lu[(16 * w + 4 * fq + r) * 128 + 16 * n + fr] = S[n][r];
        if (w == 0) *(f32x2*)(DSEG + unit * 128 + 2 * lane) = (f32x2){segtot0, segtot1}; }
    __syncthreads();
#undef HG_LOAD
}

DI void conv_tile(LAS unsigned char* lds, const Args& a, int tile, int tid, int lane, int w) {
    unsigned char* ws = a.ws; const bf16* U = (const bf16*)(ws + S_U); bf16* UB = (bf16*)a.out + (size_t)T * D;
    const float *CW = a.in[6], *CBs = a.in[7], *LG = a.in[8], *LBt = a.in[9];
    const int t0 = tile * 128, pos0 = t0 & (SEQ - 1), c2 = 2 * tid;
    LAS float* RED = (LAS float*)lds;
    f32x2 wreg[31];
    const float* cwp = CW + c2; asm volatile("" : "+v"(cwp));
#pragma unroll
    for (int j = 0; j < 31; ++j) wreg[j] = *(const f32x2*)(cwp + j * 1024);
    const f32x2 bias = *(const f32x2*)(CBs + c2), lng = *(const f32x2*)(LG + c2), lnb = *(const f32x2*)(LBt + c2);
    f32x2 win[34];
#pragma unroll
    for (int i = 0; i < 30; ++i) { unsigned wv = 0u; if (pos0 + i - 30 >= 0) wv = *(const unsigned*)(U + (size_t)(t0 + i - 30) * D + c2); win[i] = (f32x2){bflo(wv), bfhi(wv)}; }
    unsigned nx[16];
#pragma unroll
    for (int i = 0; i < 16; ++i) nx[i] = *(const unsigned*)(U + (size_t)(t0 + i) * D + c2);
    for (int g4 = 0; g4 < 8; ++g4)
#pragma unroll
    for (int gg = 0; gg < 4; ++gg) { const int g = g4 * 4 + gg;
#pragma unroll
        for (int i = 0; i < 4; ++i) win[30 + i] = (f32x2){bflo(nx[gg * 4 + i]), bfhi(nx[gg * 4 + i])};
        if (g4 < 7) {
#pragma unroll
            for (int i = 0; i < 4; ++i) nx[gg * 4 + i] = *(const unsigned*)(U + (size_t)(t0 + (g + 4) * 4 + i) * D + c2); }
        f32x2 y[4]; float av[8];
#pragma unroll
        for (int o = 0; o < 4; ++o) { f32x2 acc = bias;
#pragma unroll
            for (int j = 0; j < 31; ++j) acc += wreg[j] * win[o + j];
            y[o] = acc; av[2 * o] = acc.x + acc.y; av[2 * o + 1] = acc.x * acc.x + acc.y * acc.y; }
        float dsum;
        { const bool h32 = (lane & 32) != 0, h16 = (lane & 16) != 0, h8 = (lane & 8) != 0; float b4[4], c2[2];
#pragma unroll
          for (int k = 0; k < 4; ++k) { const float snd = h32 ? av[k] : av[4 + k], kp = h32 ? av[4 + k] : av[k]; b4[k] = kp + __shfl_xor(snd, 32); }
#pragma unroll
          for (int k = 0; k < 2; ++k) { const float snd = h16 ? b4[k] : b4[2 + k], kp = h16 ? b4[2 + k] : b4[k]; c2[k] = kp + __shfl_xor(snd, 16); }
          { const float snd = h8 ? c2[0] : c2[1], kp = h8 ? c2[1] : c2[0]; dsum = kp + __shfl_xor(snd, 8); }
          dsum += __shfl_xor(dsum, 4); dsum += __shfl_xor(dsum, 2); dsum += __shfl_xor(dsum, 1); }
        LAS float* red = RED + (g & 1) * 64;
        if ((lane & 7) == 0) { const int idx = lane >> 3; red[(idx >> 1) * 16 + w * 2 + (idx & 1)] = dsum; }
        __syncthreads();
        float tot; { const int vv = lane >> 3, ww = lane & 7; tot = red[(vv >> 1) * 16 + ww * 2 + (vv & 1)]; tot += __shfl_xor(tot, 1); tot += __shfl_xor(tot, 2); tot += __shfl_xor(tot, 4); }
#pragma unroll
        for (int o = 0; o < 4; ++o) {
            const float sm = __builtin_bit_cast(float, __builtin_amdgcn_readlane(__builtin_bit_cast(int, tot), 16 * o)), qm = __builtin_bit_cast(float, __builtin_amdgcn_readlane(__builtin_bit_cast(int, tot), 16 * o + 8));
            const float mean = sm * (1.0f / 1024.0f), var = fmaxf(qm * (1.0f / 1024.0f) - mean * mean, 0.f), rstd = 1.0f / sqrtf(var + EPS);
            const f32x2 yn = (y[o] - mean) * (lng * rstd) + lnb;
            const f32x2 sg = pg8::sigm2(yn), ov = yn * sg;
            *(unsigned*)(UB + (size_t)(t0 + g * 4 + o) * D + c2) = pk2(ov.x, ov.y); }
#pragma unroll
        for (int i = 0; i < 30; ++i) win[i] = win[i + 4];
    }
    __syncthreads();
}

DI void final_norm(const Args& a, int G, int lane, int wave) {
    const float* gf = a.in[15]; float* out = a.out; const int gw = blockIdx.x * 8 + wave, ngw = G * 8;
    f32x4 gv[4];
#pragma unroll
    for (int j = 0; j < 4; ++j) gv[j] = *(const f32x4*)(gf + 4 * lane + 256 * j);
    for (int m = gw; m < T; m += ngw) { f32x4* xr = (f32x4*)(out + (size_t)m * D) + lane; f32x4 v[4]; float s = 0.f;
#pragma unroll
        for (int j = 0; j < 4; ++j) { v[j] = xr[64 * j]; s += (v[j].x * v[j].x + v[j].y * v[j].y) + (v[j].z * v[j].z + v[j].w * v[j].w); }
        const float rstd = 1.0f / sqrtf(wave_sum(s) * (1.0f / D) + EPS);
#pragma unroll
        for (int j = 0; j < 4; ++j) xr[64 * j] = v[j] * rstd * gv[j]; }
}

#define XB_TMO      128
#define XB_XCNT(j)  (256  + 64 * (j))
#define XB_XSUB(j)  (1280 + 64 * (j))
#define XB_XGEN(j)  (2304 + 64 * (j))
#define XB_TOP      3328
#define XB_TOPGEN   3392
#define XCD_BAR_WORDS 3456
#define XB_SPIN_CAP (1u << 18)

__device__ __forceinline__ unsigned xb_ld(unsigned* p)              { return __hip_atomic_load(p, __ATOMIC_RELAXED, __HIP_MEMORY_SCOPE_AGENT); }
__device__ __forceinline__ unsigned xb_add(unsigned* p, unsigned v) { return __hip_atomic_fetch_add(p, v, __ATOMIC_RELAXED, __HIP_MEMORY_SCOPE_AGENT); }
__device__ __forceinline__ unsigned xb_xcc_id() { return (unsigned)__builtin_amdgcn_s_getreg((3 << 11) | 20) & 0xFu; }
#define XB_SPIN(cond, bar) do { unsigned _sp = 0; while (cond) { __builtin_amdgcn_s_sleep(1); \
    if ((++_sp & 255u) == 0u) { if (xb_ld(&(bar)[XB_TMO])) break; if (_sp > XB_SPIN_CAP) { atomicAdd(&(bar)[XB_TMO], 1u); break; } } } } while (0)

struct XcdBarrier {
    unsigned* bar; unsigned x;
    volatile LAS unsigned* st;
};

__device__ __forceinline__ XcdBarrier xcd_barrier_post(unsigned* bar, volatile LAS unsigned* st) {
    XcdBarrier b; b.bar = bar; b.x = xb_xcc_id(); b.st = st;
    if (threadIdx.x == 0) (void)xb_add(&bar[XB_XCNT(b.x)], 1u);
    return b;
}
__device__ __forceinline__ void xcd_barrier_complete(unsigned* bar, unsigned x, unsigned& nloc, unsigned& nx) {
    const unsigned G = gridDim.x * gridDim.y * gridDim.z;
    unsigned sum, cnt, mine, sp = 0u;
    for (;;) {
        sum = 0u; cnt = 0u; mine = 0u;
#pragma unroll
        for (unsigned j = 0; j < 16; ++j) { const unsigned c = xb_ld(&bar[XB_XCNT(j)]); sum += c; cnt += (c > 0u) ? 1u : 0u; mine = (j == x) ? c : mine; }
        if (sum == G) break;
        __builtin_amdgcn_s_sleep(1);
        if ((++sp & 255u) == 0u) { if (xb_ld(&bar[XB_TMO])) break; if (sp > XB_SPIN_CAP) { atomicAdd(&bar[XB_TMO], 1u); break; } }
    }
    nloc = mine > 0u ? mine : 1u; nx = cnt > 0u ? cnt : 1u;
}

__device__ __forceinline__ void xcd_barrier(const XcdBarrier& b) {
    asm volatile("s_waitcnt vmcnt(0)" ::: "memory");
    __syncthreads();
    if (threadIdx.x == 0) {
        unsigned* bar = b.bar;
        __builtin_amdgcn_s_waitcnt(0);
        unsigned nloc = b.st[0], nx = b.st[1];
        if (nloc == 0u) { xcd_barrier_complete(bar, b.x, nloc, nx); b.st[0] = nloc; b.st[1] = nx; }
        const unsigned old = xb_add(&bar[XB_XSUB(b.x)], 1u);
        const unsigned gen = old / nloc;
        if (old + 1u == (gen + 1u) * nloc) {
            __builtin_amdgcn_fence(__ATOMIC_RELEASE, "agent");
            asm volatile("s_waitcnt vmcnt(0)" ::: "memory");
            const unsigned og = xb_add(&bar[XB_TOP], 1u);
            const unsigned tg = og / nx;
            if (og + 1u == (tg + 1u) * nx) xb_add(&bar[XB_TOPGEN], 1u);
            else XB_SPIN(xb_ld(&bar[XB_TOPGEN]) == tg, bar);
            __builtin_amdgcn_fence(__ATOMIC_ACQUIRE, "agent");
            xb_add(&bar[XB_XGEN(b.x)], 1u);
            asm volatile("s_waitcnt vmcnt(0)" ::: "memory");
        } else {
            XB_SPIN(xb_ld(&bar[XB_XGEN(b.x)]) == gen, bar);
            __builtin_amdgcn_fence(__ATOMIC_ACQUIRE, "agent");
            asm volatile("s_waitcnt vmcnt(0)" ::: "memory");
        }
    }
    __syncthreads();
}

__global__ void __launch_bounds__(512, 2) fwd_megakernel(Args args) {
    extern __shared__ __attribute__((aligned(16))) unsigned char lds_raw[];
    LAS unsigned char* lds = (LAS unsigned char*)lds_raw;
    const int tid = threadIdx.x, lane = tid & 63, wave = __builtin_amdgcn_readfirstlane(tid >> 6);
    const int G = gridDim.x; unsigned char* ws = args.ws;
    const int lo = args.ph_lo, hi = args.ph_hi;
#define IN(k) (lo <= (k) && (k) < hi)
#ifndef PROBE_REP
#define PROBE_REP -1
#endif
#ifndef PGA
#define PGA true
#endif
#ifndef WGM_P1
#define WGM_P1 2
#endif
#ifndef WGM_P6
#define WGM_P6 2
#endif
#ifndef PGS
#define PGS true
#endif
    if (args.sync_mode != 0) cg::this_grid().sync();
    volatile LAS unsigned* xst = (volatile LAS unsigned*)(lds + LDS_MISC);
    if (tid < 2) xst[tid] = 0u;
    __syncthreads();
    XcdBarrier xbar = xcd_barrier_post((unsigned*)(ws + WS_CTL), xst);
#define SEAM(k) do { if (IN(k) && IN((k) + 1)) { xcd_barrier(xbar); if (PROBE_REP == 99) { xcd_barrier(xbar); } } } while (0)
#define REPS(k) for (int rep_ = 0; rep_ < (PROBE_REP == (k) ? 2 : 1); ++rep_)
    bf16* Qb = (bf16*)args.out; bf16* Kb = (bf16*)args.out + (size_t)T * D;

    if (IN(0)) REPS(0) { p0_prologue(args, lds, G, tid, lane, wave); __syncthreads(); }
    SEAM(0);
    if (IN(1)) {
        pg8::Gemm g{(const bf16*)(ws + S_H), (const bf16*)(ws + WS_WIN), T, DIN, D}; pg8::StaticOrder S; S.init(T, DIN, G, (int)blockIdx.x, WGM_P1); S.rot = 4;
        pg8::EpiIn E{Qb, Kb, (bf16*)(ws + S_V), (bf16*)(ws + S_GS), (bf16*)(ws + S_U), (bf16*)(ws + S_GA), (bf16*)(ws + S_GB), (bf16*)(ws + S_LF), (const float*)(ws + WS_LB)};
        pg8::gemm_phase<pg8::EpiIn, pg8::StaticOrder, false, PGS>(lds, g, S, E);
    }
#if PROBE_REP == 1
    if (IN(1)) {
        pg8::Gemm g{(const bf16*)(ws + S_H), (const bf16*)(ws + WS_WIN), T, DIN, D}; pg8::StaticOrder S; S.init(T, DIN, G, (int)blockIdx.x, WGM_P1); S.rot = 4;
        pg8::EpiIn E{Qb, Kb, (bf16*)(ws + S_V), (bf16*)(ws + S_GS), (bf16*)(ws + S_U), (bf16*)(ws + S_GA), (bf16*)(ws + S_GB), (bf16*)(ws + S_LF), (const float*)(ws + WS_LB)};
        pg8::gemm_phase<pg8::EpiIn, pg8::StaticOrder, false, PGS>(lds, g, S, E);
    }
#endif
    SEAM(1);
    if (IN(2)) {
        const bool conv_first = ((blockIdx.x >> 3) & 1) != 0;
        if (!conv_first) { REPS(20) for (int u = blockIdx.x; u < 256; u += G) if ((u & 7) != 7) hgrn_unit<false>(lds, args, u, tid, lane, wave); }
        REPS(21) for (int t = blockIdx.x; t < T / 128; t += G) conv_tile(lds, args, t, tid, lane, wave);
        if (conv_first) { REPS(20) for (int u = blockIdx.x; u < 256; u += G) if ((u & 7) != 7) hgrn_unit<false>(lds, args, u, tid, lane, wave); }
    }
    SEAM(2);
    if (IN(3)) REPS(3) {
        for (int u = blockIdx.x; u < 256; u += G) hgrn_unit<true>(lds, args, u, tid, lane, wave);
        late_weights(args, lds, G, lane, wave); __syncthreads();
    }
    SEAM(3);
    if (IN(4)) {
        pg8::Gemm g{(const bf16*)(ws + S_OA), (const bf16*)(ws + WS_WA), T, D, 2 * D, D, 16, (long)((const char*)((const bf16*)args.out + (size_t)T * D) - (const char*)(ws + S_OA)), (long)(WS_WB - WS_WA)}; pg8::StaticOrder S; S.init(T, D, G, (int)blockIdx.x);
        pg8::EpiMerge E{(bf16*)(ws + S_MG), (const bf16*)(ws + S_GA), (const bf16*)(ws + S_GB)};
        pg8::gemm_phase<pg8::EpiMerge, pg8::StaticOrder, PGA, PGS>(lds, g, S, E);
    }
#if PROBE_REP == 4
    if (IN(4)) {
        pg8::Gemm g{(const bf16*)(ws + S_OA), (const bf16*)(ws + WS_WA), T, D, 2 * D, D, 16, (long)((const char*)((const bf16*)args.out + (size_t)T * D) - (const char*)(ws + S_OA)), (long)(WS_WB - WS_WA)}; pg8::StaticOrder S; S.init(T, D, G, (int)blockIdx.x);
        pg8::EpiMerge E{(bf16*)(ws + S_MG), (const bf16*)(ws + S_GA), (const bf16*)(ws + S_GB)};
        pg8::gemm_phase<pg8::EpiMerge, pg8::StaticOrder, PGA, PGS>(lds, g, S, E);
    }
#endif
    SEAM(4);
    if (IN(5)) {
        pg8::Gemm g{(const bf16*)(ws + S_MG), (const bf16*)(ws + WS_WO), T, D, D}; pg8::StaticOrder S; S.init(T, D, G, (int)blockIdx.x);
        pg8::EpiX1 E{(const bf16*)(ws + S_H), (const float*)(ws + WS_RINV), args.in[1], (bf16*)(ws + S_X1B), (float*)(ws + WS_SS)};
        pg8::gemm_phase<pg8::EpiX1, pg8::StaticOrder, PGA, PGS>(lds, g, S, E);
    }
#if PROBE_REP == 5
    if (IN(5)) {
        pg8::Gemm g{(const bf16*)(ws + S_MG), (const bf16*)(ws + WS_WO), T, D, D}; pg8::StaticOrder S; S.init(T, D, G, (int)blockIdx.x);
        pg8::EpiX1 E{(const bf16*)(ws + S_H), (const float*)(ws + WS_RINV), args.in[1], (bf16*)(ws + S_X1B), (float*)(ws + WS_SS)};
        pg8::gemm_phase<pg8::EpiX1, pg8::StaticOrder, PGA, PGS>(lds, g, S, E);
    }
#endif
    SEAM(5);
    if (IN(6)) {
        pg8::Gemm g{(const bf16*)(ws + S_X1B), (const bf16*)(ws + WS_WMI), T, FF, D}; pg8::StaticOrder S; S.init(T, FF, G, (int)blockIdx.x, WGM_P6);
        pg8::EpiZZ E{(bf16*)(ws + S_ZZ), (const float*)(ws + WS_SS)};
        pg8::gemm_phase<pg8::EpiZZ, pg8::StaticOrder, PGA, PGS>(lds, g, S, E);
    }
#if PROBE_REP == 6
    if (IN(6)) {
        pg8::Gemm g{(const bf16*)(ws + S_X1B), (const bf16*)(ws + WS_WMI), T, FF, D}; pg8::StaticOrder S; S.init(T, FF, G, (int)blockIdx.x, WGM_P6);
        pg8::EpiZZ E{(bf16*)(ws + S_ZZ), (const float*)(ws + WS_SS)};
        pg8::gemm_phase<pg8::EpiZZ, pg8::StaticOrder, PGA, PGS>(lds, g, S, E);
    }
#endif
    SEAM(6);
#if PROBE_REP == 7
    if (IN(7)) {
        pg8::Gemm g{(const bf16*)(ws + S_ZZ), (const bf16*)(ws + WS_WMO), T, D, FF}; pg8::StaticOrder S; S.init(T, D, G, (int)blockIdx.x);
        pg8::EpiDry E{(float*)(ws + WS_SS)};
        pg8::gemm_phase<pg8::EpiDry, pg8::StaticOrder, PGA, PGS>(lds, g, S, E);
    }
#endif
#if PROBE_REP == 61
    if (IN(6)) {
        pg8::Gemm g{(const bf16*)(ws + S_X1B), (const bf16*)(ws + WS_WMI), T, FF, D}; pg8::StaticOrder S; S.init(T, FF, G, (int)blockIdx.x, WGM_P6);
        pg8::EpiDry E{(float*)(ws + WS_SS)};
        pg8::gemm_phase<pg8::EpiDry, pg8::StaticOrder, PGA, PGS>(lds, g, S, E);
    }
#endif
    if (IN(7)) {
        pg8::Gemm g{(const bf16*)(ws + S_ZZ), (const bf16*)(ws + WS_WMO), T, D, FF}; pg8::StaticOrder S; S.init(T, D, G, (int)blockIdx.x);
        pg8::EpiX2 E{(const bf16*)(ws + S_X1B), args.out, args.in[15], (float*)(ws + WS_CTL + CTL_SS2), (unsigned*)(ws + WS_CTL + CTL_CNT)};
        pg8::gemm_phase<pg8::EpiX2, pg8::StaticOrder, PGA, PGS>(lds, g, S, E);
    }
#undef IN
#undef SEAM
}

extern "C" void kernel_launch(void* const* d_in, const int* in_sizes, int n_in, void* d_out, int out_size, void* d_ws, size_t ws_size, hipStream_t stream) {
    static int grid = 0;
    if (grid == 0) {
        int dev = 0, cus = 0, per_cu = 0;
        hipGetDevice(&dev); hipDeviceGetAttribute(&cus, hipDeviceAttributeMultiprocessorCount, dev);
        hipFuncSetAttribute((const void*)fwd_megakernel, hipFuncAttributeMaxDynamicSharedMemorySize, LDS_BYTES);
        hipOccupancyMaxActiveBlocksPerMultiprocessor(&per_cu, (const void*)fwd_megakernel, 512, LDS_BYTES);
        if (per_cu < 1) { fprintf(stderr, "kernel_launch: occupancy query says %d blocks per CU\n", per_cu); per_cu = 1; }
        grid = cus * per_cu; if (grid > 256) grid = 256;
        if (ws_size < WS_END) fprintf(stderr, "kernel_launch: workspace %zu < %zu needed\n", ws_size, (size_t)WS_END);
    }
    hipMemsetAsync((unsigned char*)d_ws + WS_CTL, 0, CTL_BYTES, stream);
    Args a{};
    for (int i = 0; i < 16; ++i) a.in[i] = (const float*)d_in[i];
    a.out = (float*)d_out; a.ws = (unsigned char*)d_ws;
#if MK_N_LAUNCHES == 1
    a.ph_lo = 0; a.ph_hi = NPHASES;
    void* kargs[] = {&a};
    hipError_t e = hipLaunchCooperativeKernel((const void*)fwd_megakernel, dim3(grid), dim3(512), kargs, LDS_BYTES, stream);
    if (e != hipSuccess) fprintf(stderr, "cooperative launch failed: %s (grid %d)\n", hipGetErrorString(e), grid);
#else
    for (int p = 0; p < NPHASES; ++p) { a.ph_lo = p; a.ph_hi = p + 1; hipLaunchKernelGGL(fwd_megakernel, dim3(grid), dim3(512), LDS_BYTES, stream, a); }
#endif
}
```

```cpp
#include <hip/hip_runtime.h>
#include <hip/hip_cooperative_groups.h>
#include <cstdio>
#include <cstdint>
namespace pg8 {
#define PG8_LAS __attribute__((address_space(3)))
typedef unsigned short bf16_t;
typedef short bf16x8 __attribute__((ext_vector_type(8)));
typedef float f32x4 __attribute__((ext_vector_type(4)));
typedef unsigned u32x4 __attribute__((ext_vector_type(4)));
constexpr int BM = 256, BK = 64, HALF = 128, HTB = HALF * BK * 2  , STAGE_BYTES = 8 * HTB, NXCD = 8, WGM = 2;

__host__ __device__ __forceinline__ int lds_byte(int r, int c) { const int st = (r >> 4) * 2 + (c >> 5), rr = r & 15, cc = c & 31, ob = rr * 64 + cc * 2; return st * 1024 + (ob ^ (((ob >> 9) & 1) << 5)); }
__host__ __device__ __forceinline__ void stage_rc(int b, int& R, int& C) { const int st = b / 1024, sb = b % 1024, swz = sb ^ (((sb >> 9) & 1) << 5); R = (st >> 1) * 16 + swz / 64; C = (st & 1) * 32 + (swz % 64) / 2; }
__host__ __device__ __forceinline__ int perm32(int rho) { const int n = rho >> 4, i = rho & 15; return 8 * (i >> 2) + 4 * n + (i & 3); }

struct Unit { int pm, pn; };
struct Gemm { const bf16_t* A; const bf16_t* Bt; int M, N, K; int ld, split_kt; long splitA, splitB; };

struct StaticOrder {
    int nM, nN, nwg, G, c, wgm, rot;
    __host__ __device__ void init(int M, int N, int G_, int c_, int wgm_ = WGM) { nM = M / BM; nN = N / BM; nwg = nM * nN; G = G_; c = c_; wgm = wgm_; rot = 0; }
    __host__ __device__ bool next(int i, Unit& u) const {
        const long L = (long)i * G + c; if (L >= nwg) return false;
        int wgid = (int)L; { const int q = nwg / NXCD, r = nwg % NXCD, xcd = wgid % NXCD, off = wgid / NXCD; wgid = (xcd < r ? xcd * (q + 1) : r * (q + 1) + (xcd - r) * q) + off; }
        const int nig = wgm * nN, gid = wgid / nig, fm = gid * wgm, gsz = (nM - fm) < wgm ? (nM - fm) : wgm;
        u.pm = fm + ((wgid % nig) % gsz); u.pn = (wgid % nig) / gsz; if (rot) u.pn = (u.pn & ~15) | ((u.pn + rot * gid) & 15); return true;
    }
    __device__ __forceinline__ void a_ready(const Unit&) const {}
    __device__ __forceinline__ void done(const Unit&) const {}
};

__device__ __forceinline__ unsigned cvt_pk_bf16(float lo, float hi) { unsigned r; asm volatile("v_cvt_pk_bf16_f32 %0, %1, %2" : "=v"(r) : "v"(lo), "v"(hi)); return r; }
typedef float f32x2 __attribute__((ext_vector_type(2)));

typedef unsigned u32x2 __attribute__((ext_vector_type(2)));
typedef _Float16 f16x2 __attribute__((ext_vector_type(2)));
__device__ __forceinline__ unsigned pk_f16(float a, float b) { f16x2 v; v.x = (_Float16)a; v.y = (_Float16)b; return __builtin_bit_cast(unsigned, v); }
__device__ __forceinline__ float bf_lo(unsigned w) { return __uint_as_float(w << 16); }
__device__ __forceinline__ float bf_hi(unsigned w) { return __uint_as_float(w & 0xffff0000u); }
template <class V> __device__ __forceinline__ void st_nt(V* p, V v) { __builtin_nontemporal_store(v, p); }
__device__ __forceinline__ float sigm(float z) { return __builtin_amdgcn_rcpf(1.0f + __builtin_amdgcn_exp2f(-1.4426950409f * z)); }
__device__ __forceinline__ f32x2 exp2n2(f32x2 z) { const f32x2 t = z * (-1.4426950409f); f32x2 e; e.x = __builtin_amdgcn_exp2f(t.x); e.y = __builtin_amdgcn_exp2f(t.y); return e; }
__device__ __forceinline__ f32x2 rcp2(f32x2 d) { f32x2 r; r.x = __builtin_amdgcn_rcpf(d.x); r.y = __builtin_amdgcn_rcpf(d.y); return r; }
__device__ __forceinline__ f32x2 sigm2(f32x2 z) { return rcp2(exp2n2(z) + 1.0f); }
__device__ __forceinline__ f32x4 sigm4(f32x4 z) { const f32x2 lo = sigm2(__builtin_shufflevector(z, z, 0, 1)), hi = sigm2(__builtin_shufflevector(z, z, 2, 3)); return (f32x4){lo.x, lo.y, hi.x, hi.y}; }

struct EpiIn {
    static constexpr bool PERM = true, AFTER_DRAIN = false, HAS_MID = false; static constexpr int AUX_A = 0;
    bf16_t *Q, *KK, *V, *GS, *U, *GA, *GB; bf16_t* LF; const float* LB;
    __device__ __forceinline__ void operator()(const f32x4 (&acc)[2][2][4][2], const Unit& u, int wr, int wc, int fr, int fq) const {
        const int row0 = u.pm * BM + wr * 64 + fr; const int type = u.pn >> 2;
        if (type >= 6) {
            const int col = 128 * (u.pn - 24) + wc * 32 + 8 * fq;
#pragma unroll
            for (int ai = 0; ai < 2; ++ai)
#pragma unroll
                for (int m = 0; m < 4; ++m) { const size_t off = (size_t)(row0 + ai * HALF + m * 16) * 1024 + col; float rr[8], gb[8];
#pragma unroll
                    for (int n = 0; n < 2; ++n)
#pragma unroll
                        for (int j = 0; j < 4; j += 2) { const f32x4 za = acc[ai][0][m][n], zb = acc[ai][1][m][n];
                            const f32x2 da = exp2n2((f32x2){za[j], za[j + 1]}) + 1.0f, db = exp2n2((f32x2){zb[j], zb[j + 1]}) + 1.0f;
                            const f32x2 r2 = db * rcp2(da), g2 = rcp2(db);
                            rr[4 * n + j] = r2.x; rr[4 * n + j + 1] = r2.y; gb[4 * n + j] = g2.x; gb[4 * n + j + 1] = g2.y; }
                    u32x4 wr_, wg; wr_.x = cvt_pk_bf16(rr[0], rr[1]); wr_.y = cvt_pk_bf16(rr[2], rr[3]); wr_.z = cvt_pk_bf16(rr[4], rr[5]); wr_.w = cvt_pk_bf16(rr[6], rr[7]);
                    wg.x = cvt_pk_bf16(gb[0], gb[1]); wg.y = cvt_pk_bf16(gb[2], gb[3]); wg.z = cvt_pk_bf16(gb[4], gb[5]); wg.w = cvt_pk_bf16(gb[6], gb[7]);
                    st_nt((u32x4*)(GA + off), wr_); st_nt((u32x4*)(GB + off), wg); }
        } else if (type == 3 || type == 5) {
            const int col = 128 * (type == 3 ? u.pn - 12 : u.pn - 16) + wc * 32 + 8 * fq;
#pragma unroll
            for (int ai = 0; ai < 2; ++ai)
#pragma unroll
                for (int m = 0; m < 4; ++m) { bf16_t* rowp = U + (size_t)(row0 + ai * HALF + m * 16) * 1024 + col;
                    const f32x4 a0 = acc[ai][0][m][0], a1 = acc[ai][0][m][1], b0 = acc[ai][1][m][0], b1 = acc[ai][1][m][1];
                    const f32x4 u0 = a0 * sigm4(b0), u1 = a1 * sigm4(b1);
                    u32x4 w; w.x = cvt_pk_bf16(u0[0], u0[1]); w.y = cvt_pk_bf16(u0[2], u0[3]); w.z = cvt_pk_bf16(u1[0], u1[1]); w.w = cvt_pk_bf16(u1[2], u1[3]);
                    st_nt((u32x4*)rowp, w); }
        } else if (type == 2) {
            const int col0 = (u.pn & 3) * 256 + wc * 32 + 8 * fq;
#pragma unroll
            for (int ai = 0; ai < 2; ++ai)
#pragma unroll
                for (int m = 0; m < 4; ++m) { bf16_t* rowp = LF + (size_t)(row0 + ai * HALF + m * 16) * 1024 + col0;
#pragma unroll
                    for (int bj = 0; bj < 2; ++bj) { const f32x4 z0 = acc[ai][bj][m][0], z1 = acc[ai][bj][m][1];
                        const f32x4 s0 = sigm4(z0), s1 = sigm4(z1); u32x4 w; w.x = pk_f16(s0[0], s0[1]); w.y = pk_f16(s0[2], s0[3]); w.z = pk_f16(s1[0], s1[1]); w.w = pk_f16(s1[2], s1[3]);
                        st_nt((u32x4*)(rowp + bj * HALF), w); } }
        } else if (type == 0) plain<1>(acc, Q, u, row0, wc, fq);
        else if (type == 4) plain<0>(acc, V, u, row0, wc, fq);
        else plain<1>(acc, GS, u, row0, wc, fq);
    }
    template <int MODE  > static __device__ __forceinline__ void plain(const f32x4 (&acc)[2][2][4][2], bf16_t* dst, const Unit& u, int row0, int wc, int fq) {
        const int col0 = (u.pn & 3) * 256 + wc * 32 + 8 * fq;
#pragma unroll
        for (int ai = 0; ai < 2; ++ai)
#pragma unroll
            for (int m = 0; m < 4; ++m) { bf16_t* rowp = dst + (size_t)(row0 + ai * HALF + m * 16) * 1024 + col0;
#pragma unroll
                for (int bj = 0; bj < 2; ++bj) { f32x4 v0 = acc[ai][bj][m][0], v1 = acc[ai][bj][m][1];
                    if (MODE == 1) { v0 = v0 * sigm4(v0); v1 = v1 * sigm4(v1); }
                    u32x4 w; w.x = cvt_pk_bf16(v0[0], v0[1]); w.y = cvt_pk_bf16(v0[2], v0[3]); w.z = cvt_pk_bf16(v1[0], v1[1]); w.w = cvt_pk_bf16(v1[2], v1[3]);
                    st_nt((u32x4*)(rowp + bj * HALF), w); } }
    }
};

struct EpiMerge {
    static constexpr bool PERM = true, AFTER_DRAIN = false, HAS_MID = true; static constexpr int AUX_A = 0;
    bf16_t* MG; const bf16_t *RT, *GB;
    __device__ __forceinline__ void mid(f32x4 (&acc)[2][2][4][2], const Unit& u, int wr, int wc, int fr, int fq) const {
        int row0 = u.pm * BM + wr * 64 + fr; asm volatile("" : "+v"(row0));
        const int col0 = u.pn * 256 + wc * 32 + 8 * fq;
#pragma unroll
        for (int ai = 0; ai < 2; ++ai)
#pragma unroll
            for (int m = 0; m < 4; ++m) { const size_t off = (size_t)(row0 + ai * HALF + m * 16) * 1024 + col0;
#pragma unroll
                for (int bj = 0; bj < 2; ++bj) { const u32x4 g = *(const u32x4*)(RT + off + bj * HALF); f32x4 v0 = acc[ai][bj][m][0], v1 = acc[ai][bj][m][1];
                    v0[0] *= bf_lo(g.x); v0[1] *= bf_hi(g.x); v0[2] *= bf_lo(g.y); v0[3] *= bf_hi(g.y); v1[0] *= bf_lo(g.z); v1[1] *= bf_hi(g.z); v1[2] *= bf_lo(g.w); v1[3] *= bf_hi(g.w);
                    acc[ai][bj][m][0] = v0; acc[ai][bj][m][1] = v1; }
                if (m == 3) asm volatile("" ::: "memory"); }
    }
    __device__ __forceinline__ void operator()(const f32x4 (&acc)[2][2][4][2], const Unit& u, int wr, int wc, int fr, int fq) const {
        const int row0 = u.pm * BM + wr * 64 + fr; const int col0 = u.pn * 256 + wc * 32 + 8 * fq;
#pragma unroll
        for (int ai = 0; ai < 2; ++ai) {
            u32x4 gq[4][2];
#pragma unroll
            for (int m = 0; m < 4; ++m)
#pragma unroll
                for (int bj = 0; bj < 2; ++bj) gq[m][bj] = *(const u32x4*)(GB + (size_t)(row0 + ai * HALF + m * 16) * 1024 + col0 + bj * HALF);
#pragma unroll
            for (int m = 0; m < 4; ++m) { const size_t off = (size_t)(row0 + ai * HALF + m * 16) * 1024 + col0;
#pragma unroll
                for (int bj = 0; bj < 2; ++bj) { const u32x4 g = gq[m][bj]; f32x4 v0 = acc[ai][bj][m][0], v1 = acc[ai][bj][m][1];
                    v0[0] *= bf_lo(g.x); v0[1] *= bf_hi(g.x); v0[2] *= bf_lo(g.y); v0[3] *= bf_hi(g.y); v1[0] *= bf_lo(g.z); v1[1] *= bf_hi(g.z); v1[2] *= bf_lo(g.w); v1[3] *= bf_hi(g.w);
                    u32x4 w; w.x = cvt_pk_bf16(v0[0], v0[1]); w.y = cvt_pk_bf16(v0[2], v0[3]); w.z = cvt_pk_bf16(v1[0], v1[1]); w.w = cvt_pk_bf16(v1[2], v1[3]);
                    *(u32x4*)(MG + off + bj * HALF) = w; } } }
    }
};

struct EpiX1 {
    static constexpr bool PERM = true, AFTER_DRAIN = false, HAS_MID = false; static constexpr int AUX_A = 0;
    const bf16_t* H; const float* RINV; const float* G1; bf16_t* XB; float* SS;
    __device__ __forceinline__ void operator()(const f32x4 (&acc)[2][2][4][2], const Unit& u, int wr, int wc, int fr, int fq) const {
        const int row0 = u.pm * BM + wr * 64 + fr, col0 = u.pn * BM + wc * 32 + 8 * fq;
        f32x4 gi[2][2];
#pragma unroll
        for (int bj = 0; bj < 2; ++bj)
#pragma unroll
            for (int n = 0; n < 2; ++n) { const f32x4 g = *(const f32x4*)(G1 + col0 + bj * HALF + n * 4);
                gi[bj][n] = (f32x4){__builtin_amdgcn_rcpf(g[0]), __builtin_amdgcn_rcpf(g[1]), __builtin_amdgcn_rcpf(g[2]), __builtin_amdgcn_rcpf(g[3])}; }
#pragma unroll
        for (int ai = 0; ai < 2; ++ai) {
            u32x4 xq[4][2]; float ri[4];
#pragma unroll
            for (int m = 0; m < 4; ++m) { ri[m] = RINV[row0 + ai * HALF + m * 16];
#pragma unroll
                for (int bj = 0; bj < 2; ++bj) xq[m][bj] = *(const u32x4*)(H + (size_t)(row0 + ai * HALF + m * 16) * 1024 + col0 + bj * HALF); }
#pragma unroll
            for (int m = 0; m < 4; ++m) { const int row = row0 + ai * HALF + m * 16; const size_t off = (size_t)row * 1024 + col0; float q = 0.f;
#pragma unroll
                for (int bj = 0; bj < 2; ++bj) { const u32x4 hb = xq[m][bj];
                    const f32x4 v0 = (f32x4){bf_lo(hb.x), bf_hi(hb.x), bf_lo(hb.y), bf_hi(hb.y)} * ri[m] * gi[bj][0] + acc[ai][bj][m][0];
                    const f32x4 v1 = (f32x4){bf_lo(hb.z), bf_hi(hb.z), bf_lo(hb.w), bf_hi(hb.w)} * ri[m] * gi[bj][1] + acc[ai][bj][m][1];
                    q += ((v0[0] * v0[0] + v0[1] * v0[1]) + (v0[2] * v0[2] + v0[3] * v0[3])) + ((v1[0] * v1[0] + v1[1] * v1[1]) + (v1[2] * v1[2] + v1[3] * v1[3]));
                    u32x4 w; w.x = cvt_pk_bf16(v0[0], v0[1]); w.y = cvt_pk_bf16(v0[2], v0[3]); w.z = cvt_pk_bf16(v1[0], v1[1]); w.w = cvt_pk_bf16(v1[2], v1[3]);
                    *(u32x4*)(XB + off + bj * HALF) = w; }
                q += __shfl_xor(q, 16); q += __shfl_xor(q, 32);
                if (fq == 0) SS[(size_t)row * 16 + u.pn * 4 + wc] = q; } }
    }
};
struct EpiZZ {
    static constexpr bool PERM = true, AFTER_DRAIN = false, HAS_MID = false; static constexpr int AUX_A = 0;
    bf16_t* ZZ; const float* SS;
    __device__ __forceinline__ void operator()(const f32x4 (&acc)[2][2][4][2], const Unit& u, int wr, int wc, int fr, int fq) const {
        const int row0 = u.pm * BM + wr * 64 + fr, col0 = u.pn * BM + wc * 32 + 8 * fq;
        float r2v[2][4];
        { f32x4 pq[2][4];
#pragma unroll
          for (int ai = 0; ai < 2; ++ai)
#pragma unroll
              for (int m = 0; m < 4; ++m) pq[ai][m] = *(const f32x4*)(SS + (size_t)(row0 + ai * HALF + m * 16) * 16 + 4 * fq);
#pragma unroll
          for (int ai = 0; ai < 2; ++ai)
#pragma unroll
              for (int m = 0; m < 4; ++m) { const f32x4 p = pq[ai][m]; float s = (p[0] + p[1]) + (p[2] + p[3]); s += __shfl_xor(s, 16); s += __shfl_xor(s, 32);
                  r2v[ai][m] = __builtin_amdgcn_rcpf(s * (1.0f / 1024.0f) + 1e-6f); } }
#pragma unroll
        for (int ai = 0; ai < 2; ++ai)
#pragma unroll
            for (int m = 0; m < 4; ++m) { const int row = row0 + ai * HALF + m * 16;
                const float r2 = r2v[ai][m];
                bf16_t* rowp = ZZ + (size_t)row * 4096 + col0;
#pragma unroll
                for (int bj = 0; bj < 2; ++bj) { f32x4 v0 = acc[ai][bj][m][0], v1 = acc[ai][bj][m][1];
#pragma unroll
                    for (int j = 0; j < 4; ++j) { const float a = fmaxf(v0[j], 0.f), b = fmaxf(v1[j], 0.f); v0[j] = a * a * r2; v1[j] = b * b * r2; }
                    u32x4 w; w.x = cvt_pk_bf16(v0[0], v0[1]); w.y = cvt_pk_bf16(v0[2], v0[3]); w.z = cvt_pk_bf16(v1[0], v1[1]); w.w = cvt_pk_bf16(v1[2], v1[3]);
                    st_nt((u32x4*)(rowp + bj * HALF), w); } }
    }
};
struct EpiX2 {
    static constexpr bool PERM = false, AFTER_DRAIN = false, HAS_MID = false; static constexpr int AUX_A = 0;
    const bf16_t* XB; float* OUT; const float* GF; float* SS2; unsigned* CNT;
    __device__ __forceinline__ void operator()(const f32x4 (&acc_)[2][2][4][2], const Unit& u, int wr, int wc, int fr, int fq) const {
        f32x4 (&acc)[2][2][4][2] = const_cast<f32x4 (&)[2][2][4][2]>(acc_);
        const int row0 = u.pm * BM + wr * 64 + fr, col0 = u.pn * BM + wc * 32 + 4 * fq;
#pragma unroll
        for (int ai = 0; ai < 2; ++ai) {
            u32x2 xq[4][2][2];
#pragma unroll
            for (int m = 0; m < 4; ++m)
#pragma unroll
                for (int bj = 0; bj < 2; ++bj)
#pragma unroll
                    for (int n = 0; n < 2; ++n) xq[m][bj][n] = *(const u32x2*)(XB + (size_t)(row0 + ai * HALF + m * 16) * 1024 + col0 + bj * HALF + n * 16);
#pragma unroll
            for (int m = 0; m < 4; ++m) { const int row = row0 + ai * HALF + m * 16; float q = 0.f;
#pragma unroll
                for (int bj = 0; bj < 2; ++bj)
#pragma unroll
                    for (int n = 0; n < 2; ++n) { const u32x2 xb = xq[m][bj][n]; f32x4 v = acc[ai][bj][m][n];
                        v[0] += bf_lo(xb.x); v[1] += bf_hi(xb.x); v[2] += bf_lo(xb.y); v[3] += bf_hi(xb.y); acc[ai][bj][m][n] = v;
                        q += (v[0] * v[0] + v[1] * v[1]) + (v[2] * v[2] + v[3] * v[3]); }
                q += __shfl_xor(q, 16); q += __shfl_xor(q, 32);
                if (fq == 0) (void)__hip_atomic_fetch_add(SS2 + row, q, __ATOMIC_RELAXED, __HIP_MEMORY_SCOPE_AGENT); } }
        asm volatile("s_waitcnt vmcnt(0)" ::: "memory");
        unsigned* cnt = CNT + 64 * u.pm;
        if ((threadIdx.x & 63) == 0) (void)__hip_atomic_fetch_add(cnt, 1u, __ATOMIC_RELAXED, __HIP_MEMORY_SCOPE_AGENT);
        { unsigned sp = 0; while ((unsigned)__builtin_amdgcn_readfirstlane(__hip_atomic_load(cnt, __ATOMIC_RELAXED, __HIP_MEMORY_SCOPE_AGENT)) < 32u) { __builtin_amdgcn_s_sleep(2); if (++sp > (1u << 22)) break; } }
        __builtin_amdgcn_fence(__ATOMIC_ACQUIRE, "agent");
        f32x4 gv[2][2];
#pragma unroll
        for (int bj = 0; bj < 2; ++bj)
#pragma unroll
            for (int n = 0; n < 2; ++n) gv[bj][n] = *(const f32x4*)(GF + col0 + bj * HALF + n * 16);
        float sv[2][4];
#pragma unroll
        for (int ai = 0; ai < 2; ++ai)
#pragma unroll
            for (int m = 0; m < 4; ++m) sv[ai][m] = __hip_atomic_load(SS2 + row0 + ai * HALF + m * 16, __ATOMIC_RELAXED, __HIP_MEMORY_SCOPE_AGENT);
#pragma unroll
        for (int ai = 0; ai < 2; ++ai)
#pragma unroll
            for (int m = 0; m < 4; ++m) { const int row = row0 + ai * HALF + m * 16; float* rowp = OUT + (size_t)row * 1024 + col0;
                const float s = sv[ai][m]; const float rstd = 1.0f / sqrtf(s * (1.0f / 1024.0f) + 1e-6f);
#pragma unroll
                for (int bj = 0; bj < 2; ++bj)
#pragma unroll
                    for (int n = 0; n < 2; ++n) st_nt((f32x4*)(rowp + bj * HALF + n * 16), acc[ai][bj][m][n] * rstd * gv[bj][n]); }
    }
};

struct EpiDry {
    static constexpr bool PERM = true, AFTER_DRAIN = false, HAS_MID = false; static constexpr int AUX_A = 0;
    float* SINK;
    __device__ __forceinline__ void operator()(const f32x4 (&acc)[2][2][4][2], const Unit& u, int wr, int wc, int fr, int fq) const {
        f32x4 s = (f32x4){0.f, 0.f, 0.f, 0.f};
#pragma unroll
        for (int ai = 0; ai < 2; ++ai)
#pragma unroll
            for (int bj = 0; bj < 2; ++bj)
#pragma unroll
                for (int m = 0; m < 4; ++m)
#pragma unroll
                    for (int n = 0; n < 2; ++n) s += acc[ai][bj][m][n];
        if (s[0] + s[1] + s[2] + s[3] == 1.2345e33f) SINK[0] = s[0];
    }
};
template <class Epi, class Sched, bool ALIGN_EPI = false, bool SP2 = false>
__device__ __forceinline__ void gemm_phase(PG8_LAS unsigned char* lds, const Gemm g, const Sched& S, const Epi& E) {
    const int tid = threadIdx.x, wid = __builtin_amdgcn_readfirstlane(tid >> 6), lane = tid & 63, wr = wid >> 2, wc = wid & 3, fr = lane & 15, fq = lane >> 4;
    const int K = g.K, nt = K / BK, LD = g.ld ? g.ld : g.K, skt = g.split_kt ? g.split_kt : (1 << 30);
    unsigned voffA[2], voffB[2];
#pragma unroll
    for (int i = 0; i < 2; ++i) { int R, C; stage_rc(tid * 16 + i * 8192, R, C); const int Rb = Epi::PERM ? ((R & ~31) + perm32(R & 31)) : R;
        voffA[i] = (unsigned)(R * LD + C) * 2u; voffB[i] = (unsigned)(Rb * LD + C) * 2u; }
    const size_t kstep = (size_t)(BK * 2);
    const long adjA = g.splitA - (long)g.split_kt * (BK * 2), adjB = g.splitB - (long)g.split_kt * (BK * 2);
    const size_t hstep = (size_t)HALF * LD * 2;
    const size_t tstep = 2 * hstep;
    const unsigned ldsw = (unsigned)wid * 1024u;
    const int aoff = lds_byte(wr * 64 + fr, fq * 8), boff = lds_byte(wc * 32 + fr, fq * 8);
#define PG8_SA(b, h) (((b) * 2 + (h)) * HTB)
#define PG8_SB(b, h) ((4 + (b) * 2 + (h)) * HTB)
#define PG8_STAGE(bufoff, gbase, voff) do { _Pragma("unroll") for (int _i = 0; _i < 2; ++_i) \
        __builtin_amdgcn_global_load_lds((const unsigned*)((const char*)(gbase) + (voff)[_i]), (PG8_LAS unsigned*)(lds + (bufoff) + ldsw + _i * 8192), 16, 0, 0); } while (0)
#define PG8_LDA(dst, b, h) do { _Pragma("unroll") for (int m = 0; m < 4; ++m) _Pragma("unroll") for (int k = 0; k < 2; ++k) dst[m][k] = *(const PG8_LAS bf16x8*)(lds + PG8_SA(b, h) + aoff + m * 2048 + k * 1024); } while (0)
#define PG8_LDB(dst, b, h) do { _Pragma("unroll") for (int n = 0; n < 2; ++n) _Pragma("unroll") for (int k = 0; k < 2; ++k) dst[n][k] = *(const PG8_LAS bf16x8*)(lds + PG8_SB(b, h) + boff + n * 2048 + k * 1024); } while (0)
#define PG8_MMA(ai, bj, At, Bt) do { __builtin_amdgcn_s_setprio(1); _Pragma("unroll") for (int m = 0; m < 4; ++m) _Pragma("unroll") for (int n = 0; n < 2; ++n) _Pragma("unroll") for (int k = 0; k < 2; ++k) \
        acc[ai][bj][m][n] = __builtin_amdgcn_mfma_f32_16x16x32_bf16(Bt[n][k], At[m][k], acc[ai][bj][m][n], 0, 0, 0); __builtin_amdgcn_s_setprio(0); } while (0)
#define PG8_WAIT_V(n) asm volatile("s_waitcnt vmcnt(" #n ")" ::: "memory")
#define PG8_WAIT_L(n) asm volatile("s_waitcnt lgkmcnt(" #n ")" ::: "memory")
#define PG8_BAR __builtin_amdgcn_s_barrier()
#define PG8_SCHED __builtin_amdgcn_sched_barrier(0)
    Unit cur, nxt; int ui = 0;
    if (!S.next(0, cur)) return;
    f32x4 acc[2][2][4][2];
#pragma unroll
    for (int a = 0; a < 2; ++a)
#pragma unroll
        for (int b = 0; b < 2; ++b)
#pragma unroll
            for (int m = 0; m < 4; ++m)
#pragma unroll
                for (int n = 0; n < 2; ++n) acc[a][b][m][n] = (f32x4){0.f, 0.f, 0.f, 0.f};
    bf16x8 At[4][2], B0[2][2], B1[2][2];
    const char* cA = (const char*)g.A + (size_t)cur.pm * tstep; const char* cB = (const char*)g.Bt + (size_t)cur.pn * tstep;
    S.a_ready(cur);
    if constexpr (SP2) {
        PG8_STAGE(PG8_SB(0, 0), cB, voffB); PG8_STAGE(PG8_SB(0, 1), cB + hstep, voffB); PG8_STAGE(PG8_SA(0, 0), cA, voffA); PG8_STAGE(PG8_SA(0, 1), cA + hstep, voffA);
        if (wr == 1) PG8_BAR;
        PG8_WAIT_V(2); PG8_BAR;
        PG8_STAGE(PG8_SB(1, 0), cB + kstep, voffB); PG8_STAGE(PG8_SA(1, 0), cA + kstep, voffA); PG8_STAGE(PG8_SB(1, 1), cB + hstep + kstep, voffB);
        PG8_WAIT_V(6); PG8_BAR;
    } else {
        PG8_STAGE(PG8_SB(0, 0), cB, voffB); PG8_STAGE(PG8_SA(0, 0), cA, voffA); PG8_STAGE(PG8_SB(0, 1), cB + hstep, voffB); PG8_STAGE(PG8_SA(0, 1), cA + hstep, voffA);
        if (wr == 1) PG8_BAR;
        PG8_WAIT_V(4); PG8_BAR;
        PG8_STAGE(PG8_SB(1, 0), cB + kstep, voffB); PG8_STAGE(PG8_SA(1, 0), cA + kstep, voffA); PG8_STAGE(PG8_SB(1, 1), cB + hstep + kstep, voffB);
        PG8_WAIT_V(6); PG8_BAR;
    }
    for (;;) {
        const bool has_next = S.next(ui + 1, nxt);
        const char* nA = has_next ? (const char*)g.A + (size_t)nxt.pm * tstep : cA; const char* nB = has_next ? (const char*)g.Bt + (size_t)nxt.pn * tstep : cB;
        for (int t = 0; t < nt; t += 2) {
            const bool last = (t == nt - 2);
            const char* a1 = cA + (size_t)(t + 1) * kstep + (t + 1 >= skt ? adjA : 0);
            const char* a2 = last ? nA : cA + (size_t)(t + 2) * kstep + (t + 2 >= skt ? adjA : 0); const char* b2 = last ? nB : cB + (size_t)(t + 2) * kstep + (t + 2 >= skt ? adjB : 0);
            if constexpr (Epi::HAS_MID) { if (t == skt) E.mid(acc, cur, wr, wc, fr, fq); }
            const char* a3 = a2 + kstep; const char* b3 = b2 + kstep;
            if (last && has_next) S.a_ready(nxt);
            if constexpr (SP2) {
            PG8_LDB(B0, 0, 0); PG8_LDB(B1, 0, 1); PG8_SCHED; PG8_LDA(At, 0, 0); PG8_STAGE(PG8_SA(1, 1), a1 + hstep, voffA);
            PG8_WAIT_V(8); PG8_WAIT_L(0); PG8_BAR; PG8_MMA(0, 0, At, B0); PG8_MMA(0, 1, At, B1); PG8_BAR; PG8_SCHED;
            PG8_LDA(At, 0, 1); PG8_STAGE(PG8_SB(0, 0), b2, voffB); PG8_STAGE(PG8_SB(0, 1), b2 + hstep, voffB); PG8_STAGE(PG8_SA(0, 0), a2, voffA);
            PG8_WAIT_V(8); PG8_WAIT_L(0); PG8_BAR; PG8_MMA(1, 0, At, B0); PG8_MMA(1, 1, At, B1); PG8_BAR; PG8_SCHED;
            PG8_LDB(B0, 1, 0); PG8_LDB(B1, 1, 1); PG8_SCHED; PG8_LDA(At, 1, 0); PG8_STAGE(PG8_SA(0, 1), a2 + hstep, voffA);
            PG8_WAIT_V(8); PG8_WAIT_L(0); PG8_BAR; PG8_MMA(0, 0, At, B0); PG8_MMA(0, 1, At, B1); PG8_BAR; PG8_SCHED;
            PG8_LDA(At, 1, 1); PG8_STAGE(PG8_SB(1, 0), b3, voffB); PG8_STAGE(PG8_SB(1, 1), b3 + hstep, voffB); PG8_STAGE(PG8_SA(1, 0), a3, voffA);
            PG8_WAIT_V(8); PG8_WAIT_L(0); PG8_BAR; PG8_MMA(1, 0, At, B0); PG8_MMA(1, 1, At, B1); PG8_BAR; PG8_SCHED;
            } else {
            PG8_LDB(B0, 0, 0); PG8_SCHED; PG8_LDA(At, 0, 0); PG8_STAGE(PG8_SA(1, 1), a1 + hstep, voffA);
            PG8_WAIT_L(8); PG8_BAR; PG8_WAIT_L(0); PG8_MMA(0, 0, At, B0); PG8_BAR; PG8_SCHED;
            PG8_LDB(B1, 0, 1); PG8_STAGE(PG8_SB(0, 0), b2, voffB);
            PG8_BAR; PG8_WAIT_L(0); PG8_MMA(0, 1, At, B1); PG8_BAR;
            PG8_LDA(At, 0, 1); PG8_STAGE(PG8_SA(0, 0), a2, voffA);
            PG8_BAR; PG8_WAIT_L(0); PG8_MMA(1, 0, At, B0); PG8_BAR; PG8_SCHED;
            PG8_STAGE(PG8_SB(0, 1), b2 + hstep, voffB);
            PG8_WAIT_V(6); PG8_BAR; PG8_MMA(1, 1, At, B1); PG8_BAR;
            PG8_LDB(B0, 1, 0); PG8_SCHED; PG8_LDA(At, 1, 0); PG8_STAGE(PG8_SA(0, 1), a2 + hstep, voffA);
            PG8_WAIT_L(8); PG8_BAR; PG8_WAIT_L(0); PG8_MMA(0, 0, At, B0); PG8_BAR; PG8_SCHED;
            PG8_LDB(B1, 1, 1); PG8_STAGE(PG8_SB(1, 0), b3, voffB);
            PG8_BAR; PG8_WAIT_L(0); PG8_MMA(0, 1, At, B1); PG8_BAR;
            PG8_LDA(At, 1, 1); PG8_STAGE(PG8_SA(1, 0), a3, voffA);
            PG8_BAR; PG8_WAIT_L(0); PG8_MMA(1, 0, At, B0); PG8_BAR; PG8_SCHED;
            PG8_STAGE(PG8_SB(1, 1), b3 + hstep, voffB);
            PG8_WAIT_V(6); PG8_BAR; PG8_MMA(1, 1, At, B1); PG8_BAR;
            }
        }
        if constexpr (ALIGN_EPI) { if (wr == 0) PG8_BAR; }
        if constexpr (!Epi::AFTER_DRAIN) { E(acc, cur, wr, wc, fr, fq); S.done(cur); }
        if (!has_next) break;
#pragma unroll
        for (int a = 0; a < 2; ++a)
#pragma unroll
            for (int b = 0; b < 2; ++b)
#pragma unroll
                for (int m = 0; m < 4; ++m)
#pragma unroll
                    for (int n = 0; n < 2; ++n) acc[a][b][m][n] = (f32x4){0.f, 0.f, 0.f, 0.f};
        cur = nxt; cA = nA; cB = nB; ++ui;
        if constexpr (ALIGN_EPI) { if (wr == 1) PG8_BAR; }
    }
    PG8_WAIT_V(0);
    if constexpr (!ALIGN_EPI) { if (wr == 0) PG8_BAR; }
    PG8_BAR;
    if constexpr (Epi::AFTER_DRAIN) { E.fused(acc, cur, wr, wc, fr, fq, lds, wid, lane); S.done(cur); }
#undef PG8_SA
#undef PG8_SB
#undef PG8_STAGE
#undef PG8_LDA
#undef PG8_LDB
#undef PG8_MMA
#undef PG8_WAIT_V
#undef PG8_WAIT_L
#undef PG8_BAR
#undef PG8_SCHED
}
}

#ifndef MK_N_LAUNCHES
#define MK_N_LAUNCHES 1
#endif
namespace cg = cooperative_groups;
#define LAS __attribute__((address_space(3)))
#define DI __device__ __forceinline__
typedef unsigned short bf16;
typedef float f32x4 __attribute__((ext_vector_type(4)));
typedef float f32x2 __attribute__((ext_vector_type(2)));
typedef short bf16x8 __attribute__((ext_vector_type(8)));
typedef unsigned u32x4 __attribute__((ext_vector_type(4)));
typedef unsigned u32x2 __attribute__((ext_vector_type(2)));

constexpr int T = 32768, D = 1024, SEQ = 8192, DIN = 8192, FF = 4096;
constexpr float EPS = 1e-6f;
constexpr int NPHASES = 8;
constexpr int LDS_MISC = 131072;
constexpr int LDS_BYTES = 139264;

constexpr size_t MiB = 1u << 20;
constexpr size_t WS_WIN = 0;
constexpr size_t WS_L   = 0;
constexpr size_t WS_WA  = 16 * MiB;
constexpr size_t WS_WB  = 18 * MiB;
constexpr size_t WS_WO  = 20 * MiB;
constexpr size_t WS_WMI = 22 * MiB;
constexpr size_t WS_WMO = 30 * MiB;
constexpr size_t WS_SS  = 38 * MiB;
constexpr size_t WS_LB  = 40 * MiB;
constexpr size_t WS_DSEG = 40 * MiB + 65536;
constexpr size_t WS_CTL = 41 * MiB, CTL_CNT = 16384, CTL_SS2 = 65536, CTL_BYTES = 196608;
constexpr size_t WS_RINV = 42 * MiB;
constexpr size_t WS_END = 512 * MiB;
constexpr size_t SLOT = 64 * MiB;
constexpr size_t S_V = 1 * SLOT, S_U = 2 * SLOT, S_H = 3 * SLOT, S_LF = 4 * SLOT, S_GS = 5 * SLOT, S_GA = 6 * SLOT, S_GB = 7 * SLOT;
constexpr size_t S_X1B = S_V, S_OA = S_U, S_UB = S_H, S_MG = S_LF, S_ZZ = 2 * SLOT;

struct Args { const float* in[16]; float* out; unsigned char* ws; int ph_lo, ph_hi, sync_mode, pad; };

DI float wave_sum(float v) {
#pragma unroll
    for (int o = 1; o < 64; o <<= 1) v += __shfl_xor(v, o);
    return v;
}
DI unsigned f2bf(float f) { unsigned u = __builtin_bit_cast(unsigned, f); return (u + 0x7fffu + ((u >> 16) & 1u)) >> 16; }
typedef __bf16 bf16x2_t __attribute__((ext_vector_type(2)));
DI unsigned pk2(float lo, float hi) { f32x2 v = {lo, hi}; bf16x2_t b = __builtin_convertvector(v, bf16x2_t); return __builtin_bit_cast(unsigned, b); }
DI float bflo(unsigned w) { return __uint_as_float(w << 16); }
DI float bfhi(unsigned w) { return __uint_as_float(w & 0xffff0000u); }
DI float ex2(float x) { return __builtin_amdgcn_exp2f(x); }

DI void p0_transpose_item(const float* W, int K, int N, bf16* WT, int k0, int n0, int src_n0, const float* kscale, LAS float* scr, int lane) {
    float wv[32];
#pragma unroll
    for (int i = 0; i < 32; ++i) wv[i] = __builtin_nontemporal_load(W + (size_t)(k0 + 2 * i + (lane >> 5)) * N + src_n0 + (lane & 31));
#pragma unroll
    for (int i = 0; i < 32; ++i) { const int kk = 2 * i + (lane >> 5); float v = wv[i]; if (kscale) v *= kscale[k0 + kk]; scr[kk * 33 + (lane & 31)] = v; }
    asm volatile("s_waitcnt lgkmcnt(0)" ::: "memory");
    const int c = lane & 7;
#pragma unroll
    for (int j = 0; j < 4; ++j) { const int n = (lane >> 3) + 8 * j; const LAS float* s = scr + (8 * c) * 33 + n;
        u32x4 o; o.x = pk2(s[0 * 33], s[1 * 33]); o.y = pk2(s[2 * 33], s[3 * 33]); o.z = pk2(s[4 * 33], s[5 * 33]); o.w = pk2(s[6 * 33], s[7 * 33]);
        *(u32x4*)(WT + (size_t)(n0 + n) * K + k0 + 8 * c) = o; }
    asm volatile("s_waitcnt lgkmcnt(0)" ::: "memory");
}
DI void p0_matrix(const float* W, int K, int N, bf16* WT, const float* kscale, bool glu, LAS float* scr, int gw, int ngw, int lane) {
    const int nblk = N / 32, items = (K / 64) * nblk;
    for (int it = gw; it < items; it += ngw) { const int kb = it / nblk, nb = it % nblk; const int n0 = nb * 32; int src = n0;
        if (glu) {
            const int tile = n0 >> 8, r = n0 & 255;
            if (tile < 4) src = n0;
            else if (tile < 8) src = 3072 + (n0 - 1024);
            else if (tile < 12) src = 1024 + (n0 - 2048);
            else if (tile < 16) src = 4096 + (r >> 7) * 1024 + 128 * (tile - 12) + (r & 127);
            else if (tile < 20) src = 2048 + (n0 - 4096);
            else if (tile < 24) src = 4096 + (r >> 7) * 1024 + 128 * (tile - 20 + 4) + (r & 127);
            else src = 6144 + (r >> 7) * 1024 + 128 * (tile - 24) + (r & 127); }
        p0_transpose_item(W, K, N, WT, kb * 64, n0, src, kscale, scr, lane); }
}
DI void p0_prologue(const Args& a, LAS unsigned char* lds, int G, int tid, int lane, int wave) {
    LAS float* scr = (LAS float*)(lds + wave * 16384);
    const int gw = blockIdx.x * 8 + wave, ngw = G * 8;
    unsigned char* ws = a.ws;
    p0_matrix(a.in[2], D, DIN, (bf16*)(ws + WS_WIN), nullptr, true, scr, gw, ngw, lane);
    if (blockIdx.x == 0) { const float* lp = a.in[3]; float* LB = (float*)(ws + WS_LB);
        for (int c = tid; c < 1024; c += 512) LB[c] = 1.0f / (1.0f + __expf(lp[1024 + c] - lp[c])); }
    const float* x = a.in[0]; const float* g1 = a.in[1]; bf16* H = (bf16*)(ws + S_H);
    f32x4 gv[4];
#pragma unroll
    for (int j = 0; j < 4; ++j) gv[j] = *(const f32x4*)(g1 + 4 * lane + 256 * j);
    f32x4 nxv[4], nyv[4];
    if (gw < T) {
#pragma unroll
        for (int j = 0; j < 4; ++j) nxv[j] = __builtin_nontemporal_load((const f32x4*)(x + (size_t)gw * D) + lane + 64 * j); }
    if (gw + ngw < T) {
#pragma unroll
        for (int j = 0; j < 4; ++j) nyv[j] = __builtin_nontemporal_load((const f32x4*)(x + (size_t)(gw + ngw) * D) + lane + 64 * j); }
    for (int m = gw; m < T; m += ngw) { f32x4 v[4]; float s = 0.f;
#pragma unroll
        for (int j = 0; j < 4; ++j) { v[j] = nxv[j]; nxv[j] = nyv[j]; }
        if (m + 2 * ngw < T) {
#pragma unroll
            for (int j = 0; j < 4; ++j) nyv[j] = __builtin_nontemporal_load((const f32x4*)(x + (size_t)(m + 2 * ngw) * D) + lane + 64 * j); }
#pragma unroll
        for (int j = 0; j < 4; ++j) s += (v[j].x * v[j].x + v[j].y * v[j].y) + (v[j].z * v[j].z + v[j].w * v[j].w);
        const float rms = sqrtf(wave_sum(s) * (1.0f / D) + EPS), rstd = 1.0f / rms; if (lane == 0) ((float*)(ws + WS_RINV))[m] = rms;
        u32x2* o = (u32x2*)(H + (size_t)m * D) + lane;
#pragma unroll
        for (int j = 0; j < 4; ++j) { u32x2 w; w.x = pk2(v[j].x * rstd * gv[j].x, v[j].y * rstd * gv[j].y); w.y = pk2(v[j].z * rstd * gv[j].z, v[j].w * rstd * gv[j].w); o[64 * j] = w; } }
}

DI void late_weights(const Args& a, LAS unsigned char* lds, int G, int lane, int wave) {
    LAS float* scr = (LAS float*)(lds + wave * 16384);
    const int gw = blockIdx.x * 8 + wave, ngw = G * 8;
    unsigned char* ws = a.ws;
    p0_matrix(a.in[5], D, D, (bf16*)(ws + WS_WA), nullptr, false, scr, gw, ngw, lane);
    p0_matrix(a.in[10], D, D, (bf16*)(ws + WS_WB), nullptr, false, scr, gw, ngw, lane);
    p0_matrix(a.in[11], D, D, (bf16*)(ws + WS_WO), nullptr, false, scr, gw, ngw, lane);
    p0_matrix(a.in[13], D, FF, (bf16*)(ws + WS_WMI), a.in[12], false, scr, gw, ngw, lane);
    p0_matrix(a.in[14], FF, D, (bf16*)(ws + WS_WMO), nullptr, false, scr, gw, ngw, lane);
}

constexpr int HQ_QT = 0, HQ_KT = 17408, HQ_KDT = 34816, HQ_VT = 53248, HQ_PP = 71680, HQ_ST = 80896, HQ_TOT = 115712, HQ_DV = 119808, HQ_SSQ = 120320;
constexpr int PA = 272, PB = 144;
DI bf16x8 ldfrag(const LAS unsigned char* base, int pitch, int row0, int k0, int lane) {
    return *(const LAS bf16x8*)(base + (row0 + (lane & 15)) * pitch + (k0 + 8 * (lane >> 4)) * 2);
}
#define MFMA16(a, b, c) __builtin_amdgcn_mfma_f32_16x16x32_bf16((a), (b), (c), 0, 0, 0)

template <bool PASS2>
DI void hgrn_unit(LAS unsigned char* lds, const Args& a, int unit, int tid, int lane, int w) {
    unsigned char* ws = a.ws;
    const bf16* Qb = (const bf16*)a.out;
    const bf16* Vb = (const bf16*)(ws + S_V); const bf16* LFb = (const bf16*)(ws + S_LF); const bf16* GSb = (const bf16*)(ws + S_GS); bf16* OA = (bf16*)(ws + S_OA);
    float* Lst = (float*)(ws + WS_L); float* DSEG = (float*)(ws + WS_DSEG); const float* HG = a.in[4];
    const int bh = unit >> 3, seg = unit & 7, b = bh >> 3, h = bh & 7;
    const size_t tok0 = (size_t)b * SEQ + (size_t)seg * 1024; const int cb = h * 128;
    const int fr = lane & 15, fq = lane >> 4;
    LAS float* TOT = (LAS float*)(lds + HQ_TOT); LAS float* DV = (LAS float*)(lds + HQ_DV); LAS float* SSQ = (LAS float*)(lds + HQ_SSQ);
    f32x4 S[8];
#pragma unroll
    for (int n = 0; n < 8; ++n) S[n] = (f32x4){0.f, 0.f, 0.f, 0.f};
    float segtot0 = 0.f, segtot1 = 0.f;
    const f32x2 lbv = *(const f32x2*)((const float*)(ws + WS_LB) + cb + 2 * lane); const f32x2 omlv = (f32x2){1.0f - lbv.x, 1.0f - lbv.y};
    f32x2 gh = (f32x2){1.f, 1.f};
    if (PASS2) {
        gh = *(const f32x2*)(HG + 2 * lane);
        float Lr[32], Dr[4];
#define HG_LLOAD(ii) do { const float* Li_ = Lst + (size_t)(bh * 8 + (ii)) * 16384 + (16 * w + 4 * fq) * 128 + fr; const float* Di_ = DSEG + (bh * 8 + (ii)) * 128 + 16 * w + 4 * fq; \
            _Pragma("unroll") for (int r = 0; r < 4; ++r) Dr[r] = Di_[r]; \
            _Pragma("unroll") for (int n = 0; n < 8; ++n) _Pragma("unroll") for (int r = 0; r < 4; ++r) Lr[n * 4 + r] = Li_[r * 128 + 16 * n]; } while (0)
        if (seg > 0) HG_LLOAD(0);
        for (int i = 0; i < seg; ++i) { float Lc[32], dd[4];
#pragma unroll
            for (int r = 0; r < 4; ++r) dd[r] = ex2(Dr[r]);
#pragma unroll
            for (int k = 0; k < 32; ++k) Lc[k] = Lr[k];
            if (i + 1 < seg) HG_LLOAD(i + 1);
#pragma unroll
            for (int n = 0; n < 8; ++n)
#pragma unroll
                for (int r = 0; r < 4; ++r) S[n][r] = S[n][r] * dd[r] + Lc[n * 4 + r]; }
#undef HG_LLOAD
#pragma unroll
        for (int n = 0; n < 8; ++n) { u32x2 pk; pk.x = pk2(S[n][0], S[n][1]); pk.y = pk2(S[n][2], S[n][3]); *(LAS u32x2*)(lds + HQ_ST + (16 * n + fr) * PA + (16 * w + 4 * fq) * 2) = pk; }
    }
    unsigned nlf[8], nv[8], nq[8], ngs[8];
#define HG_LOAD(cc) do { const size_t rb_ = tok0 + (size_t)(cc) * 64 + 8 * w; _Pragma("unroll") for (int i = 0; i < 8; ++i) { const size_t off = (rb_ + i) * D + cb + 2 * lane; \
            nlf[i] = *(const unsigned*)(LFb + off); nv[i] = *(const unsigned*)(Vb + off); if (PASS2) { nq[i] = *(const unsigned*)(Qb + off); ngs[i] = *(const unsigned*)(GSb + off); } } } while (0)
    HG_LOAD(0);
    for (int c = 0; c < 16; ++c) {
        unsigned vr[8], qr[8], gsc[8];
#pragma unroll
        for (int i = 0; i < 8; ++i) { vr[i] = nv[i]; if (PASS2) { qr[i] = nq[i]; gsc[i] = ngs[i]; } }
        f32x2 pl[8], kf[8]; f32x2 run = (f32x2){1.f, 1.f};
#pragma unroll
        for (int i = 0; i < 8; ++i) { const pg8::f16x2 hv = __builtin_bit_cast(pg8::f16x2, nlf[i]); const f32x2 s2 = (f32x2){(float)hv.x, (float)hv.y};
            run = run * (lbv + omlv * s2); pl[i] = run; kf[i] = omlv - omlv * s2; }
        *(LAS f32x2*)(TOT + w * 128 + 2 * lane) = run;
        __syncthreads();
        f32x2 pre = (f32x2){1.f, 1.f}, tot = (f32x2){1.f, 1.f};
#pragma unroll
        for (int ww = 0; ww < 8; ++ww) { const f32x2 t = *(const LAS f32x2*)(TOT + ww * 128 + 2 * lane); tot = tot * t; if (ww < w) pre = pre * t; }
        segtot0 += __builtin_amdgcn_logf(tot.x); segtot1 += __builtin_amdgcn_logf(tot.y);
        unsigned kd0[4], kd1[4];
#pragma unroll
        for (int i = 0; i < 8; i += 2) {
            f32x2 kd[2];
#pragma unroll
            for (int e = 0; e < 2; ++e) { const int ii = i + e; f32x2 E = pre * pl[ii]; E.x = fmaxf(E.x, 2.4e-35f); E.y = fmaxf(E.y, 2.4e-35f);
                const f32x2 inv = (f32x2){__builtin_amdgcn_rcpf(E.x), __builtin_amdgcn_rcpf(E.y)}; const f32x2 kt = kf[ii] * inv; kd[e] = kt * tot;
                if (PASS2) { const f32x2 q2 = (f32x2){bflo(qr[ii]), bfhi(qr[ii])} * E;
                    *(LAS unsigned*)(lds + HQ_QT + (8 * w + ii) * PA + 4 * lane) = pk2(q2.x, q2.y);
                    *(LAS unsigned*)(lds + HQ_KT + (8 * w + ii) * PA + 4 * lane) = pk2(kt.x, kt.y); } }
            kd0[i >> 1] = pk2(kd[0].x, kd[1].x); kd1[i >> 1] = pk2(kd[0].y, kd[1].y); }
        *(LAS u32x4*)(lds + HQ_KDT + (2 * lane) * PB + 16 * w) = (u32x4){kd0[0], kd0[1], kd0[2], kd0[3]};
        *(LAS u32x4*)(lds + HQ_KDT + (2 * lane + 1) * PB + 16 * w) = (u32x4){kd1[0], kd1[1], kd1[2], kd1[3]};
        { u32x4 v0, v1;
          v0.x = (vr[0] & 0xffffu) | (vr[1] << 16); v0.y = (vr[2] & 0xffffu) | (vr[3] << 16); v0.z = (vr[4] & 0xffffu) | (vr[5] << 16); v0.w = (vr[6] & 0xffffu) | (vr[7] << 16);
          v1.x = (vr[0] >> 16) | (vr[1] & 0xffff0000u); v1.y = (vr[2] >> 16) | (vr[3] & 0xffff0000u); v1.z = (vr[4] >> 16) | (vr[5] & 0xffff0000u); v1.w = (vr[6] >> 16) | (vr[7] & 0xffff0000u);
          *(LAS u32x4*)(lds + HQ_VT + (2 * lane) * PB + 16 * w) = v0; *(LAS u32x4*)(lds + HQ_VT + (2 * lane + 1) * PB + 16 * w) = v1; }
        if (w == 0) *(LAS f32x2*)(DV + 2 * lane) = tot;
        __syncthreads();
        if (c < 15) HG_LOAD(c + 1);
        if (PASS2) {
            const int tt = w & 3;
#pragma unroll
            for (int e = 0; e < 2; ++e) { const int st = 2 * (w >> 2) + e; f32x4 sc = (f32x4){0.f, 0.f, 0.f, 0.f};
                if (st <= tt) {
#pragma unroll
                    for (int ks = 0; ks < 4; ++ks) sc = MFMA16(ldfrag(lds + HQ_KT, PA, 16 * st, 32 * ks, lane), ldfrag(lds + HQ_QT, PA, 16 * tt, 32 * ks, lane), sc); }
                const int t = 16 * tt + fr, s0 = 16 * st + 4 * fq;
#pragma unroll
                for (int r = 0; r < 4; ++r) if (s0 + r > t) sc[r] = 0.f;
                u32x2 pk; pk.x = pk2(sc[0], sc[1]); pk.y = pk2(sc[2], sc[3]);
                *(LAS u32x2*)(lds + HQ_PP + t * PB + s0 * 2) = pk; }
            __syncthreads();
            const int mt = w & 3; f32x4 o[4];
#pragma unroll
            for (int j = 0; j < 4; ++j) o[j] = (f32x4){0.f, 0.f, 0.f, 0.f};
#pragma unroll
            for (int ks = 0; ks < 4; ++ks) { const bf16x8 bq = ldfrag(lds + HQ_QT, PA, 16 * mt, 32 * ks, lane);
#pragma unroll
                for (int j = 0; j < 4; ++j) o[j] = MFMA16(ldfrag(lds + HQ_ST, PA, 16 * (4 * (w >> 2) + j), 32 * ks, lane), bq, o[j]); }
#pragma unroll
            for (int ks = 0; ks < 2; ++ks) { const bf16x8 bp = ldfrag(lds + HQ_PP, PB, 16 * mt, 32 * ks, lane);
#pragma unroll
                for (int j = 0; j < 4; ++j) o[j] = MFMA16(ldfrag(lds + HQ_VT, PB, 16 * (4 * (w >> 2) + j), 32 * ks, lane), bp, o[j]); }
            float q = 0.f;
#pragma unroll
            for (int j = 0; j < 4; ++j) q += (o[j][0] * o[j][0] + o[j][1] * o[j][1]) + (o[j][2] * o[j][2] + o[j][3] * o[j][3]);
            q += __shfl_xor(q, 16); q += __shfl_xor(q, 32);
            if (fq == 0) SSQ[(16 * mt + fr) * 2 + (w >> 2)] = q;
            __syncthreads();
            { const f32x2 s2 = *(const LAS f32x2*)(SSQ + (16 * mt + fr) * 2); const float rstd = __builtin_amdgcn_rsqf((s2.x + s2.y) * (1.0f / 128.0f) + EPS);
#pragma unroll
              for (int j = 0; j < 4; ++j) { u32x2 pk; pk.x = pk2(o[j][0] * rstd, o[j][1] * rstd); pk.y = pk2(o[j][2] * rstd, o[j][3] * rstd);
                  *(LAS u32x2*)(lds + HQ_KT + (16 * mt + fr) * PA + (16 * (4 * (w >> 2) + j) + 4 * fq) * 2) = pk; } }
            __syncthreads();
#pragma unroll
            for (int i = 0; i < 8; ++i) { const unsigned ot = *(const LAS unsigned*)(lds + HQ_KT + (8 * w + i) * PA + 4 * lane);
                *(unsigned*)(OA + (tok0 + (size_t)c * 64 + 8 * w + i) * D + cb + 2 * lane) = pk2(bflo(ot) * gh.x * bflo(gsc[i]), bfhi(ot) * gh.y * bfhi(gsc[i])); }
        }
        { float dd[4];
#pragma unroll
          for (int r = 0; r < 4; ++r) dd[r] = DV[16 * w + 4 * fq + r];
          const bf16x8 a0 = ldfrag(lds + HQ_KDT, PB, 16 * w, 0, lane), a1 = ldfrag(lds + HQ_KDT, PB, 16 * w, 32, lane);
#pragma unroll
          for (int n = 0; n < 8; ++n) {
#pragma unroll
              for (int r = 0; r < 4; ++r) S[n][r] *= dd[r];
              S[n] = MFMA16(a0, ldfrag(lds + HQ_VT, PB, 16 * n, 0, lane), S[n]); S[n] = MFMA16(a1, ldfrag(lds + HQ_VT, PB, 16 * n, 32, lane), S[n]); }
          if (PASS2) {
#pragma unroll
              for (int n = 0; n < 8; ++n) { u32x2 pk; pk.x = pk2(S[n][0], S[n][1]); pk.y = pk2(S[n][2], S[n][3]); *(LAS u32x2*)(lds + HQ_ST + (16 * n + fr) * PA + (16 * w + 4 * fq) * 2) = pk; } }
        }
    }
    if (!PASS2) { float* Lu = Lst + (size_t)unit * 16384;
#pragma unroll
        for (int n = 0; n < 8; ++n)
#pragma unroll
            for (int r = 0; r < 4; ++r) Lu[(16 * w + 4 * fq + r) * 128 + 16 * n + fr] = S[n][r];
        if (w == 0) *(f32x2*)(DSEG + unit * 128 + 2 * lane) = (f32x2){segtot0, segtot1}; }
    __syncthreads();
#undef HG_LOAD
}

DI void conv_tile(LAS unsigned char* lds, const Args& a, int tile, int tid, int lane, int w) {
    unsigned char* ws = a.ws; const bf16* U = (const bf16*)(ws + S_U); bf16* UB = (bf16*)a.out + (size_t)T * D;
    const float *CW = a.in[6], *CBs = a.in[7], *LG = a.in[8], *LBt = a.in[9];
    const int t0 = tile * 128, pos0 = t0 & (SEQ - 1), c2 = 2 * tid;
    LAS float* RED = (LAS float*)lds;
    f32x2 wreg[31];
    const float* cwp = CW + c2; asm volatile("" : "+v"(cwp));
#pragma unroll
    for (int j = 0; j < 31; ++j) wreg[j] = *(const f32x2*)(cwp + j * 1024);
    const f32x2 bias = *(const f32x2*)(CBs + c2), lng = *(const f32x2*)(LG + c2), lnb = *(const f32x2*)(LBt + c2);
    f32x2 win[34];
#pragma unroll
    for (int i = 0; i < 30; ++i) { unsigned wv = 0u; if (pos0 + i - 30 >= 0) wv = *(const unsigned*)(U + (size_t)(t0 + i - 30) * D + c2); win[i] = (f32x2){bflo(wv), bfhi(wv)}; }
    unsigned nx[16];
#pragma unroll
    for (int i = 0; i < 16; ++i) nx[i] = *(const unsigned*)(U + (size_t)(t0 + i) * D + c2);
    for (int g4 = 0; g4 < 8; ++g4)
#pragma unroll
    for (int gg = 0; gg < 4; ++gg) { const int g = g4 * 4 + gg;
#pragma unroll
        for (int i = 0; i < 4; ++i) win[30 + i] = (f32x2){bflo(nx[gg * 4 + i]), bfhi(nx[gg * 4 + i])};
        if (g4 < 7) {
#pragma unroll
            for (int i = 0; i < 4; ++i) nx[gg * 4 + i] = *(const unsigned*)(U + (size_t)(t0 + (g + 4) * 4 + i) * D + c2); }
        f32x2 y[4]; float av[8];
#pragma unroll
        for (int o = 0; o < 4; ++o) y[o] = bias;
#pragma unroll
        for (int j = 0; j < 31; ++j)
#pragma unroll
            for (int o = 0; o < 4; ++o) y[o] += wreg[j] * win[o + j];
#pragma unroll
        for (int o = 0; o < 4; ++o) { av[2 * o] = y[o].x + y[o].y; av[2 * o + 1] = y[o].x * y[o].x + y[o].y * y[o].y; }
        float dsum;
        { const bool h32 = (lane & 32) != 0, h16 = (lane & 16) != 0, h8 = (lane & 8) != 0; float b4[4], c2[2];
#pragma unroll
          for (int k = 0; k < 4; ++k) { const float snd = h32 ? av[k] : av[4 + k], kp = h32 ? av[4 + k] : av[k]; b4[k] = kp + __shfl_xor(snd, 32); }
#pragma unroll
          for (int k = 0; k < 2; ++k) { const float snd = h16 ? b4[k] : b4[2 + k], kp = h16 ? b4[2 + k] : b4[k]; c2[k] = kp + __shfl_xor(snd, 16); }
          { const float snd = h8 ? c2[0] : c2[1], kp = h8 ? c2[1] : c2[0]; dsum = kp + __shfl_xor(snd, 8); }
          dsum += __shfl_xor(dsum, 4); dsum += __shfl_xor(dsum, 2); dsum += __shfl_xor(dsum, 1); }
        LAS float* red = RED + (g & 1) * 64;
        if ((lane & 7) == 0) { const int idx = lane >> 3; red[(idx >> 1) * 16 + w * 2 + (idx & 1)] = dsum; }
        __syncthreads();
        float tot; { const int vv = lane >> 3, ww = lane & 7; tot = red[(vv >> 1) * 16 + ww * 2 + (vv & 1)]; tot += __shfl_xor(tot, 1); tot += __shfl_xor(tot, 2); tot += __shfl_xor(tot, 4); }
#pragma unroll
        for (int o = 0; o < 4; ++o) {
            const float sm = __builtin_bit_cast(float, __builtin_amdgcn_readlane(__builtin_bit_cast(int, tot), 16 * o)), qm = __builtin_bit_cast(float, __builtin_amdgcn_readlane(__builtin_bit_cast(int, tot), 16 * o + 8));
            const float mean = sm * (1.0f / 1024.0f), var = fmaxf(qm * (1.0f / 1024.0f) - mean * mean, 0.f), rstd = __builtin_amdgcn_rsqf(var + EPS);
            const f32x2 yn = (y[o] - mean) * (lng * rstd) + lnb;
            const f32x2 sg = pg8::sigm2(yn), ov = yn * sg;
            *(unsigned*)(UB + (size_t)(t0 + g * 4 + o) * D + c2) = pk2(ov.x, ov.y); }
#pragma unroll
        for (int i = 0; i < 30; ++i) win[i] = win[i + 4];
    }
    __syncthreads();
}

DI void final_norm(const Args& a, int G, int lane, int wave) {
    const float* gf = a.in[15]; float* out = a.out; const int gw = blockIdx.x * 8 + wave, ngw = G * 8;
    f32x4 gv[4];
#pragma unroll
    for (int j = 0; j < 4; ++j) gv[j] = *(const f32x4*)(gf + 4 * lane + 256 * j);
    for (int m = gw; m < T; m += ngw) { f32x4* xr = (f32x4*)(out + (size_t)m * D) + lane; f32x4 v[4]; float s = 0.f;
#pragma unroll
        for (int j = 0; j < 4; ++j) { v[j] = xr[64 * j]; s += (v[j].x * v[j].x + v[j].y * v[j].y) + (v[j].z * v[j].z + v[j].w * v[j].w); }
        const float rstd = 1.0f / sqrtf(wave_sum(s) * (1.0f / D) + EPS);
#pragma unroll
        for (int j = 0; j < 4; ++j) xr[64 * j] = v[j] * rstd * gv[j]; }
}

#define XB_TMO      128
#define XB_XCNT(j)  (256  + 64 * (j))
#define XB_XSUB(j)  (1280 + 64 * (j))
#define XB_XGEN(j)  (2304 + 64 * (j))
#define XB_TOP      3328
#define XB_TOPGEN   3392
#define XCD_BAR_WORDS 3456
#define XB_SPIN_CAP (1u << 18)

__device__ __forceinline__ unsigned xb_ld(unsigned* p)              { return __hip_atomic_load(p, __ATOMIC_RELAXED, __HIP_MEMORY_SCOPE_AGENT); }
__device__ __forceinline__ unsigned xb_add(unsigned* p, unsigned v) { return __hip_atomic_fetch_add(p, v, __ATOMIC_RELAXED, __HIP_MEMORY_SCOPE_AGENT); }
__device__ __forceinline__ unsigned xb_xcc_id() { return (unsigned)__builtin_amdgcn_s_getreg((3 << 11) | 20) & 0xFu; }
#define XB_SPIN(cond, bar) do { unsigned _sp = 0; while (cond) { __builtin_amdgcn_s_sleep(1); \
    if ((++_sp & 255u) == 0u) { if (xb_ld(&(bar)[XB_TMO])) break; if (_sp > XB_SPIN_CAP) { atomicAdd(&(bar)[XB_TMO], 1u); break; } } } } while (0)

struct XcdBarrier {
    unsigned* bar; unsigned x;
    volatile LAS unsigned* st;
};

__device__ __forceinline__ XcdBarrier xcd_barrier_post(unsigned* bar, volatile LAS unsigned* st) {
    XcdBarrier b; b.bar = bar; b.x = xb_xcc_id(); b.st = st;
    if (threadIdx.x == 0) (void)xb_add(&bar[XB_XCNT(b.x)], 1u);
    return b;
}
__device__ __forceinline__ void xcd_barrier_complete(unsigned* bar, unsigned x, unsigned& nloc, unsigned& nx) {
    const unsigned G = gridDim.x * gridDim.y * gridDim.z;
    unsigned sum, cnt, mine, sp = 0u;
    for (;;) {
        sum = 0u; cnt = 0u; mine = 0u;
#pragma unroll
        for (unsigned j = 0; j < 16; ++j) { const unsigned c = xb_ld(&bar[XB_XCNT(j)]); sum += c; cnt += (c > 0u) ? 1u : 0u; mine = (j == x) ? c : mine; }
        if (sum == G) break;
        __builtin_amdgcn_s_sleep(1);
        if ((++sp & 255u) == 0u) { if (xb_ld(&bar[XB_TMO])) break; if (sp > XB_SPIN_CAP) { atomicAdd(&bar[XB_TMO], 1u); break; } }
    }
    nloc = mine > 0u ? mine : 1u; nx = cnt > 0u ? cnt : 1u;
}

__device__ __forceinline__ void xcd_barrier(const XcdBarrier& b) {
    asm volatile("s_waitcnt vmcnt(0)" ::: "memory");
    __syncthreads();
    if (threadIdx.x == 0) {
        unsigned* bar = b.bar;
        __builtin_amdgcn_s_waitcnt(0);
        unsigned nloc = b.st[0], nx = b.st[1];
        if (nloc == 0u) { xcd_barrier_complete(bar, b.x, nloc, nx); b.st[0] = nloc; b.st[1] = nx; }
        const unsigned old = xb_add(&bar[XB_XSUB(b.x)], 1u);
        const unsigned gen = old / nloc;
        if (old + 1u == (gen + 1u) * nloc) {
            __builtin_amdgcn_fence(__ATOMIC_RELEASE, "agent");
            asm volatile("s_waitcnt vmcnt(0)" ::: "memory");
            const unsigned og = xb_add(&bar[XB_TOP], 1u);
            const unsigned tg = og / nx;
            if (og + 1u == (tg + 1u) * nx) xb_add(&bar[XB_TOPGEN], 1u);
            else XB_SPIN(xb_ld(&bar[XB_TOPGEN]) == tg, bar);
            __builtin_amdgcn_fence(__ATOMIC_ACQUIRE, "agent");
            xb_add(&bar[XB_XGEN(b.x)], 1u);
            asm volatile("s_waitcnt vmcnt(0)" ::: "memory");
        } else {
            XB_SPIN(xb_ld(&bar[XB_XGEN(b.x)]) == gen, bar);
            __builtin_amdgcn_fence(__ATOMIC_ACQUIRE, "agent");
            asm volatile("s_waitcnt vmcnt(0)" ::: "memory");
        }
    }
    __syncthreads();
}

__global__ void __launch_bounds__(512, 2) fwd_megakernel(Args args) {
    extern __shared__ __attribute__((aligned(16))) unsigned char lds_raw[];
    LAS unsigned char* lds = (LAS unsigned char*)lds_raw;
    const int tid = threadIdx.x, lane = tid & 63, wave = __builtin_amdgcn_readfirstlane(tid >> 6);
    const int G = gridDim.x; unsigned char* ws = args.ws;
    const int lo = args.ph_lo, hi = args.ph_hi;
#define IN(k) (lo <= (k) && (k) < hi)
#ifndef PROBE_REP
#define PROBE_REP -1
#endif
#ifndef PGA
#define PGA true
#endif
#ifndef WGM_P1
#define WGM_P1 2
#endif
#ifndef WGM_P6
#define WGM_P6 2
#endif
#ifndef PGS
#define PGS true
#endif
    if (args.sync_mode != 0) cg::this_grid().sync();
    volatile LAS unsigned* xst = (volatile LAS unsigned*)(lds + LDS_MISC);
    if (tid < 2) xst[tid] = 0u;
    __syncthreads();
    XcdBarrier xbar = xcd_barrier_post((unsigned*)(ws + WS_CTL), xst);
#define SEAM(k) do { if (IN(k) && IN((k) + 1)) { xcd_barrier(xbar); if (PROBE_REP == 99) { xcd_barrier(xbar); } } } while (0)
#define REPS(k) for (int rep_ = 0; rep_ < (PROBE_REP == (k) ? 2 : 1); ++rep_)
    bf16* Qb = (bf16*)args.out; bf16* Kb = (bf16*)args.out + (size_t)T * D;

    if (IN(0)) REPS(0) { p0_prologue(args, lds, G, tid, lane, wave); __syncthreads(); }
    SEAM(0);
    if (IN(1)) {
        pg8::Gemm g{(const bf16*)(ws + S_H), (const bf16*)(ws + WS_WIN), T, DIN, D}; pg8::StaticOrder S; S.init(T, DIN, G, (int)blockIdx.x, WGM_P1); S.rot = 4;
        pg8::EpiIn E{Qb, Kb, (bf16*)(ws + S_V), (bf16*)(ws + S_GS), (bf16*)(ws + S_U), (bf16*)(ws + S_GA), (bf16*)(ws + S_GB), (bf16*)(ws + S_LF), (const float*)(ws + WS_LB)};
        pg8::gemm_phase<pg8::EpiIn, pg8::StaticOrder, false, PGS>(lds, g, S, E);
    }
#if PROBE_REP == 1
    if (IN(1)) {
        pg8::Gemm g{(const bf16*)(ws + S_H), (const bf16*)(ws + WS_WIN), T, DIN, D}; pg8::StaticOrder S; S.init(T, DIN, G, (int)blockIdx.x, WGM_P1); S.rot = 4;
        pg8::EpiIn E{Qb, Kb, (bf16*)(ws + S_V), (bf16*)(ws + S_GS), (bf16*)(ws + S_U), (bf16*)(ws + S_GA), (bf16*)(ws + S_GB), (bf16*)(ws + S_LF), (const float*)(ws + WS_LB)};
        pg8::gemm_phase<pg8::EpiIn, pg8::StaticOrder, false, PGS>(lds, g, S, E);
    }
#endif
    SEAM(1);
    if (IN(2)) {
        const bool conv_first = ((blockIdx.x >> 3) & 1) != 0;
        if (!conv_first) { REPS(20) for (int u = blockIdx.x; u < 256; u += G) if ((u & 7) != 7) hgrn_unit<false>(lds, args, u, tid, lane, wave); }
        REPS(21) for (int t = blockIdx.x; t < T / 128; t += G) conv_tile(lds, args, t, tid, lane, wave);
        if (conv_first) { REPS(20) for (int u = blockIdx.x; u < 256; u += G) if ((u & 7) != 7) hgrn_unit<false>(lds, args, u, tid, lane, wave); }
    }
    SEAM(2);
    if (IN(3)) REPS(3) {
        for (int u = blockIdx.x; u < 256; u += G) hgrn_unit<true>(lds, args, u, tid, lane, wave);
        late_weights(args, lds, G, lane, wave); __syncthreads();
    }
    SEAM(3);
    if (IN(4)) {
        pg8::Gemm g{(const bf16*)(ws + S_OA), (const bf16*)(ws + WS_WA), T, D, 2 * D, D, 16, (long)((const char*)((const bf16*)args.out + (size_t)T * D) - (const char*)(ws + S_OA)), (long)(WS_WB - WS_WA)}; pg8::StaticOrder S; S.init(T, D, G, (int)blockIdx.x);
        pg8::EpiMerge E{(bf16*)(ws + S_MG), (const bf16*)(ws + S_GA), (const bf16*)(ws + S_GB)};
        pg8::gemm_phase<pg8::EpiMerge, pg8::StaticOrder, PGA, PGS>(lds, g, S, E);
    }
#if PROBE_REP == 4
    if (IN(4)) {
        pg8::Gemm g{(const bf16*)(ws + S_OA), (const bf16*)(ws + WS_WA), T, D, 2 * D, D, 16, (long)((const char*)((const bf16*)args.out + (size_t)T * D) - (const char*)(ws + S_OA)), (long)(WS_WB - WS_WA)}; pg8::StaticOrder S; S.init(T, D, G, (int)blockIdx.x);
        pg8::EpiMerge E{(bf16*)(ws + S_MG), (const bf16*)(ws + S_GA), (const bf16*)(ws + S_GB)};
        pg8::gemm_phase<pg8::EpiMerge, pg8::StaticOrder, PGA, PGS>(lds, g, S, E);
    }
#endif
    SEAM(4);
    if (IN(5)) {
        pg8::Gemm g{(const bf16*)(ws + S_MG), (const bf16*)(ws + WS_WO), T, D, D}; pg8::StaticOrder S; S.init(T, D, G, (int)blockIdx.x);
        pg8::EpiX1 E{(const bf16*)(ws + S_H), (const float*)(ws + WS_RINV), args.in[1], (bf16*)(ws + S_X1B), (float*)(ws + WS_SS)};
        pg8::gemm_phase<pg8::EpiX1, pg8::StaticOrder, PGA, PGS>(lds, g, S, E);
    }
#if PROBE_REP == 5
    if (IN(5)) {
        pg8::Gemm g{(const bf16*)(ws + S_MG), (const bf16*)(ws + WS_WO), T, D, D}; pg8::StaticOrder S; S.init(T, D, G, (int)blockIdx.x);
        pg8::EpiX1 E{(const bf16*)(ws + S_H), (const float*)(ws + WS_RINV), args.in[1], (bf16*)(ws + S_X1B), (float*)(ws + WS_SS)};
        pg8::gemm_phase<pg8::EpiX1, pg8::StaticOrder, PGA, PGS>(lds, g, S, E);
    }
#endif
    SEAM(5);
    if (IN(6)) {
        pg8::Gemm g{(const bf16*)(ws + S_X1B), (const bf16*)(ws + WS_WMI), T, FF, D}; pg8::StaticOrder S; S.init(T, FF, G, (int)blockIdx.x, WGM_P6);
        pg8::EpiZZ E{(bf16*)(ws + S_ZZ), (const float*)(ws + WS_SS)};
        pg8::gemm_phase<pg8::EpiZZ, pg8::StaticOrder, PGA, PGS>(lds, g, S, E);
    }
#if PROBE_REP == 6
    if (IN(6)) {
        pg8::Gemm g{(const bf16*)(ws + S_X1B), (const bf16*)(ws + WS_WMI), T, FF, D}; pg8::StaticOrder S; S.init(T, FF, G, (int)blockIdx.x, WGM_P6);
        pg8::EpiZZ E{(bf16*)(ws + S_ZZ), (const float*)(ws + WS_SS)};
        pg8::gemm_phase<pg8::EpiZZ, pg8::StaticOrder, PGA, PGS>(lds, g, S, E);
    }
#endif
    SEAM(6);
#if PROBE_REP == 7
    if (IN(7)) {
        pg8::Gemm g{(const bf16*)(ws + S_ZZ), (const bf16*)(ws + WS_WMO), T, D, FF}; pg8::StaticOrder S; S.init(T, D, G, (int)blockIdx.x);
        pg8::EpiDry E{(float*)(ws + WS_SS)};
        pg8::gemm_phase<pg8::EpiDry, pg8::StaticOrder, PGA, PGS>(lds, g, S, E);
    }
#endif
#if PROBE_REP == 61
    if (IN(6)) {
        pg8::Gemm g{(const bf16*)(ws + S_X1B), (const bf16*)(ws + WS_WMI), T, FF, D}; pg8::StaticOrder S; S.init(T, FF, G, (int)blockIdx.x, WGM_P6);
        pg8::EpiDry E{(float*)(ws + WS_SS)};
        pg8::gemm_phase<pg8::EpiDry, pg8::StaticOrder, PGA, PGS>(lds, g, S, E);
    }
#endif
    if (IN(7)) {
        pg8::Gemm g{(const bf16*)(ws + S_ZZ), (const bf16*)(ws + WS_WMO), T, D, FF}; pg8::StaticOrder S; S.init(T, D, G, (int)blockIdx.x);
        pg8::EpiX2 E{(const bf16*)(ws + S_X1B), args.out, args.in[15], (float*)(ws + WS_CTL + CTL_SS2), (unsigned*)(ws + WS_CTL + CTL_CNT)};
        pg8::gemm_phase<pg8::EpiX2, pg8::StaticOrder, PGA, PGS>(lds, g, S, E);
    }
#undef IN
#undef SEAM
}

extern "C" void kernel_launch(void* const* d_in, const int* in_sizes, int n_in, void* d_out, int out_size, void* d_ws, size_t ws_size, hipStream_t stream) {
    static int grid = 0;
    if (grid == 0) {
        int dev = 0, cus = 0, per_cu = 0;
        hipGetDevice(&dev); hipDeviceGetAttribute(&cus, hipDeviceAttributeMultiprocessorCount, dev);
        hipFuncSetAttribute((const void*)fwd_megakernel, hipFuncAttributeMaxDynamicSharedMemorySize, LDS_BYTES);
        hipOccupancyMaxActiveBlocksPerMultiprocessor(&per_cu, (const void*)fwd_megakernel, 512, LDS_BYTES);
        if (per_cu < 1) { fprintf(stderr, "kernel_launch: occupancy query says %d blocks per CU\n", per_cu); per_cu = 1; }
        grid = cus * per_cu; if (grid > 256) grid = 256;
        if (ws_size < WS_END) fprintf(stderr, "kernel_launch: workspace %zu < %zu needed\n", ws_size, (size_t)WS_END);
    }
    hipMemsetAsync((unsigned char*)d_ws + WS_CTL, 0, CTL_BYTES, stream);
    Args a{};
    for (int i = 0; i < 16; ++i) a.in[i] = (const float*)d_in[i];
    a.out = (float*)d_out; a.ws = (unsigned char*)d_ws;
#if MK_N_LAUNCHES == 1
    a.ph_lo = 0; a.ph_hi = NPHASES;
    void* kargs[] = {&a};
    hipError_t e = hipLaunchCooperativeKernel((const void*)fwd_megakernel, dim3(grid), dim3(512), kargs, LDS_BYTES, stream);
    if (e != hipSuccess) fprintf(stderr, "cooperative launch failed: %s (grid %d)\n", hipGetErrorString(e), grid);
#else
    for (int p = 0; p < NPHASES; ++p) { a.ph_lo = p; a.ph_hi = p + 1; hipLaunchKernelGGL(fwd_megakernel, dim3(grid), dim3(512), LDS_BYTES, stream, a); }
#endif
}
```

```cpp
#include <hip/hip_runtime.h>
#include <hip/hip_cooperative_groups.h>
#include <cstdio>
#include <cstdint>
namespace pg8 {
#define PG8_LAS __attribute__((address_space(3)))
typedef unsigned short bf16_t;
typedef short bf16x8 __attribute__((ext_vector_type(8)));
typedef float f32x4 __attribute__((ext_vector_type(4)));
typedef unsigned u32x4 __attribute__((ext_vector_type(4)));
constexpr int BM = 256, BK = 64, HALF = 128, HTB = HALF * BK * 2  , STAGE_BYTES = 8 * HTB, NXCD = 8, WGM = 2;

__host__ __device__ __forceinline__ int lds_byte(int r, int c) { const int st = (r >> 4) * 2 + (c >> 5), rr = r & 15, cc = c & 31, ob = rr * 64 + cc * 2; return st * 1024 + (ob ^ (((ob >> 9) & 1) << 5)); }
__host__ __device__ __forceinline__ void stage_rc(int b, int& R, int& C) { const int st = b / 1024, sb = b % 1024, swz = sb ^ (((sb >> 9) & 1) << 5); R = (st >> 1) * 16 + swz / 64; C = (st & 1) * 32 + (swz % 64) / 2; }
__host__ __device__ __forceinline__ int perm32(int rho) { const int n = rho >> 4, i = rho & 15; return 8 * (i >> 2) + 4 * n + (i & 3); }

struct Unit { int pm, pn; };
struct Gemm { const bf16_t* A; const bf16_t* Bt; int M, N, K; int ld, split_kt; long splitA, splitB; };

struct StaticOrder {
    int nM, nN, nwg, G, c, wgm, rot;
    __host__ __device__ void init(int M, int N, int G_, int c_, int wgm_ = WGM) { nM = M / BM; nN = N / BM; nwg = nM * nN; G = G_; c = c_; wgm = wgm_; rot = 0; }
    __host__ __device__ bool next(int i, Unit& u) const {
        const long L = (long)i * G + c; if (L >= nwg) return false;
        int wgid = (int)L; { const int q = nwg / NXCD, r = nwg % NXCD, xcd = wgid % NXCD, off = wgid / NXCD; wgid = (xcd < r ? xcd * (q + 1) : r * (q + 1) + (xcd - r) * q) + off; }
        const int nig = wgm * nN, gid = wgid / nig, fm = gid * wgm, gsz = (nM - fm) < wgm ? (nM - fm) : wgm;
        u.pm = fm + ((wgid % nig) % gsz); u.pn = (wgid % nig) / gsz; if (rot) u.pn = (u.pn & ~15) | ((u.pn + rot * gid) & 15); return true;
    }
    __device__ __forceinline__ void a_ready(const Unit&) const {}
    __device__ __forceinline__ void done(const Unit&) const {}
};

__device__ __forceinline__ unsigned cvt_pk_bf16(float lo, float hi) { unsigned r; asm volatile("v_cvt_pk_bf16_f32 %0, %1, %2" : "=v"(r) : "v"(lo), "v"(hi)); return r; }
typedef float f32x2 __attribute__((ext_vector_type(2)));

typedef unsigned u32x2 __attribute__((ext_vector_type(2)));
typedef _Float16 f16x2 __attribute__((ext_vector_type(2)));
__device__ __forceinline__ unsigned pk_f16(float a, float b) { f16x2 v; v.x = (_Float16)a; v.y = (_Float16)b; return __builtin_bit_cast(unsigned, v); }
__device__ __forceinline__ float bf_lo(unsigned w) { return __uint_as_float(w << 16); }
__device__ __forceinline__ float bf_hi(unsigned w) { return __uint_as_float(w & 0xffff0000u); }
template <class V> __device__ __forceinline__ void st_nt(V* p, V v) { __builtin_nontemporal_store(v, p); }
__device__ __forceinline__ float sigm(float z) { return __builtin_amdgcn_rcpf(1.0f + __builtin_amdgcn_exp2f(-1.4426950409f * z)); }
__device__ __forceinline__ f32x2 exp2n2(f32x2 z) { const f32x2 t = z * (-1.4426950409f); f32x2 e; e.x = __builtin_amdgcn_exp2f(t.x); e.y = __builtin_amdgcn_exp2f(t.y); return e; }
__device__ __forceinline__ f32x2 rcp2(f32x2 d) { f32x2 r; r.x = __builtin_amdgcn_rcpf(d.x); r.y = __builtin_amdgcn_rcpf(d.y); return r; }
__device__ __forceinline__ f32x2 sigm2(f32x2 z) { return rcp2(exp2n2(z) + 1.0f); }
__device__ __forceinline__ f32x4 sigm4(f32x4 z) { const f32x2 lo = sigm2(__builtin_shufflevector(z, z, 0, 1)), hi = sigm2(__builtin_shufflevector(z, z, 2, 3)); return (f32x4){lo.x, lo.y, hi.x, hi.y}; }

struct EpiIn {
    static constexpr bool PERM = true, AFTER_DRAIN = false, HAS_MID = false; static constexpr int AUX_A = 0;
    bf16_t *Q, *KK, *V, *GS, *U, *GA, *GB; bf16_t* LF; const float* LB;
    __device__ __forceinline__ void operator()(const f32x4 (&acc)[2][2][4][2], const Unit& u, int wr, int wc, int fr, int fq) const {
        const int row0 = u.pm * BM + wr * 64 + fr; const int type = u.pn >> 2;
        if (type >= 6) {
            const int col = 128 * (u.pn - 24) + wc * 32 + 8 * fq;
#pragma unroll
            for (int ai = 0; ai < 2; ++ai)
#pragma unroll
                for (int m = 0; m < 4; ++m) { const size_t off = (size_t)(row0 + ai * HALF + m * 16) * 1024 + col; float rr[8], gb[8];
#pragma unroll
                    for (int n = 0; n < 2; ++n)
#pragma unroll
                        for (int j = 0; j < 4; j += 2) { const f32x4 za = acc[ai][0][m][n], zb = acc[ai][1][m][n];
                            const f32x2 da = exp2n2((f32x2){za[j], za[j + 1]}) + 1.0f, db = exp2n2((f32x2){zb[j], zb[j + 1]}) + 1.0f;
                            const f32x2 r2 = db * rcp2(da), g2 = rcp2(db);
                            rr[4 * n + j] = r2.x; rr[4 * n + j + 1] = r2.y; gb[4 * n + j] = g2.x; gb[4 * n + j + 1] = g2.y; }
                    u32x4 wr_, wg; wr_.x = cvt_pk_bf16(rr[0], rr[1]); wr_.y = cvt_pk_bf16(rr[2], rr[3]); wr_.z = cvt_pk_bf16(rr[4], rr[5]); wr_.w = cvt_pk_bf16(rr[6], rr[7]);
                    wg.x = cvt_pk_bf16(gb[0], gb[1]); wg.y = cvt_pk_bf16(gb[2], gb[3]); wg.z = cvt_pk_bf16(gb[4], gb[5]); wg.w = cvt_pk_bf16(gb[6], gb[7]);
                    st_nt((u32x4*)(GA + off), wr_); st_nt((u32x4*)(GB + off), wg); }
        } else if (type == 3 || type == 5) {
            const int col = 128 * (type == 3 ? u.pn - 12 : u.pn - 16) + wc * 32 + 8 * fq;
#pragma unroll
            for (int ai = 0; ai < 2; ++ai)
#pragma unroll
                for (int m = 0; m < 4; ++m) { bf16_t* rowp = U + (size_t)(row0 + ai * HALF + m * 16) * 1024 + col;
                    const f32x4 a0 = acc[ai][0][m][0], a1 = acc[ai][0][m][1], b0 = acc[ai][1][m][0], b1 = acc[ai][1][m][1];
                    const f32x4 u0 = a0 * sigm4(b0), u1 = a1 * sigm4(b1);
                    u32x4 w; w.x = cvt_pk_bf16(u0[0], u0[1]); w.y = cvt_pk_bf16(u0[2], u0[3]); w.z = cvt_pk_bf16(u1[0], u1[1]); w.w = cvt_pk_bf16(u1[2], u1[3]);
                    st_nt((u32x4*)rowp, w); }
        } else if (type == 2) {
            const int col0 = (u.pn & 3) * 256 + wc * 32 + 8 * fq;
#pragma unroll
            for (int ai = 0; ai < 2; ++ai)
#pragma unroll
                for (int m = 0; m < 4; ++m) { bf16_t* rowp = LF + (size_t)(row0 + ai * HALF + m * 16) * 1024 + col0;
#pragma unroll
                    for (int bj = 0; bj < 2; ++bj) { const f32x4 z0 = acc[ai][bj][m][0], z1 = acc[ai][bj][m][1];
                        const f32x4 s0 = sigm4(z0), s1 = sigm4(z1); u32x4 w; w.x = pk_f16(s0[0], s0[1]); w.y = pk_f16(s0[2], s0[3]); w.z = pk_f16(s1[0], s1[1]); w.w = pk_f16(s1[2], s1[3]);
                        st_nt((u32x4*)(rowp + bj * HALF), w); } }
        } else if (type == 0) plain<1>(acc, Q, u, row0, wc, fq);
        else if (type == 4) plain<0>(acc, V, u, row0, wc, fq);
        else plain<1>(acc, GS, u, row0, wc, fq);
    }
    template <int MODE  > static __device__ __forceinline__ void plain(const f32x4 (&acc)[2][2][4][2], bf16_t* dst, const Unit& u, int row0, int wc, int fq) {
        const int col0 = (u.pn & 3) * 256 + wc * 32 + 8 * fq;
#pragma unroll
        for (int ai = 0; ai < 2; ++ai)
#pragma unroll
            for (int m = 0; m < 4; ++m) { bf16_t* rowp = dst + (size_t)(row0 + ai * HALF + m * 16) * 1024 + col0;
#pragma unroll
                for (int bj = 0; bj < 2; ++bj) { f32x4 v0 = acc[ai][bj][m][0], v1 = acc[ai][bj][m][1];
                    if (MODE == 1) { v0 = v0 * sigm4(v0); v1 = v1 * sigm4(v1); }
                    u32x4 w; w.x = cvt_pk_bf16(v0[0], v0[1]); w.y = cvt_pk_bf16(v0[2], v0[3]); w.z = cvt_pk_bf16(v1[0], v1[1]); w.w = cvt_pk_bf16(v1[2], v1[3]);
                    st_nt((u32x4*)(rowp + bj * HALF), w); } }
    }
};

struct EpiMerge {
    static constexpr bool PERM = true, AFTER_DRAIN = false, HAS_MID = true; static constexpr int AUX_A = 0;
    bf16_t* MG; const bf16_t *RT, *GB;
    __device__ __forceinline__ void mid(f32x4 (&acc)[2][2][4][2], const Unit& u, int wr, int wc, int fr, int fq) const {
        int row0 = u.pm * BM + wr * 64 + fr; asm volatile("" : "+v"(row0));
        const int col0 = u.pn * 256 + wc * 32 + 8 * fq;
#pragma unroll
        for (int ai = 0; ai < 2; ++ai)
#pragma unroll
            for (int m = 0; m < 4; ++m) { const size_t off = (size_t)(row0 + ai * HALF + m * 16) * 1024 + col0;
#pragma unroll
                for (int bj = 0; bj < 2; ++bj) { const u32x4 g = *(const u32x4*)(RT + off + bj * HALF); f32x4 v0 = acc[ai][bj][m][0], v1 = acc[ai][bj][m][1];
                    v0[0] *= bf_lo(g.x); v0[1] *= bf_hi(g.x); v0[2] *= bf_lo(g.y); v0[3] *= bf_hi(g.y); v1[0] *= bf_lo(g.z); v1[1] *= bf_hi(g.z); v1[2] *= bf_lo(g.w); v1[3] *= bf_hi(g.w);
                    acc[ai][bj][m][0] = v0; acc[ai][bj][m][1] = v1; }
                if (m == 3) asm volatile("" ::: "memory"); }
    }
    __device__ __forceinline__ void operator()(const f32x4 (&acc)[2][2][4][2], const Unit& u, int wr, int wc, int fr, int fq) const {
        const int row0 = u.pm * BM + wr * 64 + fr; const int col0 = u.pn * 256 + wc * 32 + 8 * fq;
#pragma unroll
        for (int ai = 0; ai < 2; ++ai) {
            u32x4 gq[4][2];
#pragma unroll
            for (int m = 0; m < 4; ++m)
#pragma unroll
                for (int bj = 0; bj < 2; ++bj) gq[m][bj] = *(const u32x4*)(GB + (size_t)(row0 + ai * HALF + m * 16) * 1024 + col0 + bj * HALF);
#pragma unroll
            for (int m = 0; m < 4; ++m) { const size_t off = (size_t)(row0 + ai * HALF + m * 16) * 1024 + col0;
#pragma unroll
                for (int bj = 0; bj < 2; ++bj) { const u32x4 g = gq[m][bj]; f32x4 v0 = acc[ai][bj][m][0], v1 = acc[ai][bj][m][1];
                    v0[0] *= bf_lo(g.x); v0[1] *= bf_hi(g.x); v0[2] *= bf_lo(g.y); v0[3] *= bf_hi(g.y); v1[0] *= bf_lo(g.z); v1[1] *= bf_hi(g.z); v1[2] *= bf_lo(g.w); v1[3] *= bf_hi(g.w);
                    u32x4 w; w.x = cvt_pk_bf16(v0[0], v0[1]); w.y = cvt_pk_bf16(v0[2], v0[3]); w.z = cvt_pk_bf16(v1[0], v1[1]); w.w = cvt_pk_bf16(v1[2], v1[3]);
                    *(u32x4*)(MG + off + bj * HALF) = w; } } }
    }
};

struct EpiX1 {
    static constexpr bool PERM = true, AFTER_DRAIN = false, HAS_MID = false; static constexpr int AUX_A = 0;
    const bf16_t* H; const float* RINV; const float* G1; bf16_t* XB; float* SS;
    __device__ __forceinline__ void operator()(const f32x4 (&acc)[2][2][4][2], const Unit& u, int wr, int wc, int fr, int fq) const {
        const int row0 = u.pm * BM + wr * 64 + fr, col0 = u.pn * BM + wc * 32 + 8 * fq;
        f32x4 gi[2][2];
#pragma unroll
        for (int bj = 0; bj < 2; ++bj)
#pragma unroll
            for (int n = 0; n < 2; ++n) { const f32x4 g = *(const f32x4*)(G1 + col0 + bj * HALF + n * 4);
                gi[bj][n] = (f32x4){__builtin_amdgcn_rcpf(g[0]), __builtin_amdgcn_rcpf(g[1]), __builtin_amdgcn_rcpf(g[2]), __builtin_amdgcn_rcpf(g[3])}; }
#pragma unroll
        for (int ai = 0; ai < 2; ++ai) {
            u32x4 xq[4][2]; float ri[4];
#pragma unroll
            for (int m = 0; m < 4; ++m) { ri[m] = RINV[row0 + ai * HALF + m * 16];
#pragma unroll
                for (int bj = 0; bj < 2; ++bj) xq[m][bj] = *(const u32x4*)(H + (size_t)(row0 + ai * HALF + m * 16) * 1024 + col0 + bj * HALF); }
#pragma unroll
            for (int m = 0; m < 4; ++m) { const int row = row0 + ai * HALF + m * 16; const size_t off = (size_t)row * 1024 + col0; float q = 0.f;
#pragma unroll
                for (int bj = 0; bj < 2; ++bj) { const u32x4 hb = xq[m][bj];
                    const f32x4 v0 = (f32x4){bf_lo(hb.x), bf_hi(hb.x), bf_lo(hb.y), bf_hi(hb.y)} * ri[m] * gi[bj][0] + acc[ai][bj][m][0];
                    const f32x4 v1 = (f32x4){bf_lo(hb.z), bf_hi(hb.z), bf_lo(hb.w), bf_hi(hb.w)} * ri[m] * gi[bj][1] + acc[ai][bj][m][1];
                    q += ((v0[0] * v0[0] + v0[1] * v0[1]) + (v0[2] * v0[2] + v0[3] * v0[3])) + ((v1[0] * v1[0] + v1[1] * v1[1]) + (v1[2] * v1[2] + v1[3] * v1[3]));
                    u32x4 w; w.x = cvt_pk_bf16(v0[0], v0[1]); w.y = cvt_pk_bf16(v0[2], v0[3]); w.z = cvt_pk_bf16(v1[0], v1[1]); w.w = cvt_pk_bf16(v1[2], v1[3]);
                    *(u32x4*)(XB + off + bj * HALF) = w; }
                q += __shfl_xor(q, 16); q += __shfl_xor(q, 32);
                if (fq == 0) SS[(size_t)row * 16 + u.pn * 4 + wc] = q; } }
    }
};
struct EpiZZ {
    static constexpr bool PERM = true, AFTER_DRAIN = false, HAS_MID = false; static constexpr int AUX_A = 0;
    bf16_t* ZZ; const float* SS;
    __device__ __forceinline__ void operator()(const f32x4 (&acc)[2][2][4][2], const Unit& u, int wr, int wc, int fr, int fq) const {
        const int row0 = u.pm * BM + wr * 64 + fr, col0 = u.pn * BM + wc * 32 + 8 * fq;
        float r2v[2][4];
        { f32x4 pq[2][4];
#pragma unroll
          for (int ai = 0; ai < 2; ++ai)
#pragma unroll
              for (int m = 0; m < 4; ++m) pq[ai][m] = *(const f32x4*)(SS + (size_t)(row0 + ai * HALF + m * 16) * 16 + 4 * fq);
#pragma unroll
          for (int ai = 0; ai < 2; ++ai)
#pragma unroll
              for (int m = 0; m < 4; ++m) { const f32x4 p = pq[ai][m]; float s = (p[0] + p[1]) + (p[2] + p[3]); s += __shfl_xor(s, 16); s += __shfl_xor(s, 32);
                  r2v[ai][m] = __builtin_amdgcn_rcpf(s * (1.0f / 1024.0f) + 1e-6f); } }
#pragma unroll
        for (int ai = 0; ai < 2; ++ai)
#pragma unroll
            for (int m = 0; m < 4; ++m) { const int row = row0 + ai * HALF + m * 16;
                const float r2 = r2v[ai][m];
                bf16_t* rowp = ZZ + (size_t)row * 4096 + col0;
#pragma unroll
                for (int bj = 0; bj < 2; ++bj) { f32x4 v0 = acc[ai][bj][m][0], v1 = acc[ai][bj][m][1];
#pragma unroll
                    for (int j = 0; j < 4; ++j) { const float a = fmaxf(v0[j], 0.f), b = fmaxf(v1[j], 0.f); v0[j] = a * a * r2; v1[j] = b * b * r2; }
                    u32x4 w; w.x = cvt_pk_bf16(v0[0], v0[1]); w.y = cvt_pk_bf16(v0[2], v0[3]); w.z = cvt_pk_bf16(v1[0], v1[1]); w.w = cvt_pk_bf16(v1[2], v1[3]);
                    st_nt((u32x4*)(rowp + bj * HALF), w); } }
    }
};
struct EpiX2 {
    static constexpr bool PERM = false, AFTER_DRAIN = false, HAS_MID = false; static constexpr int AUX_A = 0;
    const bf16_t* XB; float* OUT; const float* GF; float* SS2; unsigned* CNT;
    __device__ __forceinline__ void operator()(const f32x4 (&acc_)[2][2][4][2], const Unit& u, int wr, int wc, int fr, int fq) const {
        f32x4 (&acc)[2][2][4][2] = const_cast<f32x4 (&)[2][2][4][2]>(acc_);
        const int row0 = u.pm * BM + wr * 64 + fr, col0 = u.pn * BM + wc * 32 + 4 * fq;
#pragma unroll
        for (int ai = 0; ai < 2; ++ai) {
            u32x2 xq[4][2][2];
#pragma unroll
            for (int m = 0; m < 4; ++m)
#pragma unroll
                for (int bj = 0; bj < 2; ++bj)
#pragma unroll
                    for (int n = 0; n < 2; ++n) xq[m][bj][n] = *(const u32x2*)(XB + (size_t)(row0 + ai * HALF + m * 16) * 1024 + col0 + bj * HALF + n * 16);
#pragma unroll
            for (int m = 0; m < 4; ++m) { const int row = row0 + ai * HALF + m * 16; float q = 0.f;
#pragma unroll
                for (int bj = 0; bj < 2; ++bj)
#pragma unroll
                    for (int n = 0; n < 2; ++n) { const u32x2 xb = xq[m][bj][n]; f32x4 v = acc[ai][bj][m][n];
                        v[0] += bf_lo(xb.x); v[1] += bf_hi(xb.x); v[2] += bf_lo(xb.y); v[3] += bf_hi(xb.y); acc[ai][bj][m][n] = v;
                        q += (v[0] * v[0] + v[1] * v[1]) + (v[2] * v[2] + v[3] * v[3]); }
                q += __shfl_xor(q, 16); q += __shfl_xor(q, 32);
                if (fq == 0) (void)__hip_atomic_fetch_add(SS2 + row, q, __ATOMIC_RELAXED, __HIP_MEMORY_SCOPE_AGENT); } }
        asm volatile("s_waitcnt vmcnt(0)" ::: "memory");
        unsigned* cnt = CNT + 64 * u.pm;
        if ((threadIdx.x & 63) == 0) (void)__hip_atomic_fetch_add(cnt, 1u, __ATOMIC_RELAXED, __HIP_MEMORY_SCOPE_AGENT);
        { unsigned sp = 0; while ((unsigned)__builtin_amdgcn_readfirstlane(__hip_atomic_load(cnt, __ATOMIC_RELAXED, __HIP_MEMORY_SCOPE_AGENT)) < 32u) { __builtin_amdgcn_s_sleep(2); if (++sp > (1u << 22)) break; } }
        __builtin_amdgcn_fence(__ATOMIC_ACQUIRE, "agent");
        f32x4 gv[2][2];
#pragma unroll
        for (int bj = 0; bj < 2; ++bj)
#pragma unroll
            for (int n = 0; n < 2; ++n) gv[bj][n] = *(const f32x4*)(GF + col0 + bj * HALF + n * 16);
        float sv[2][4];
#pragma unroll
        for (int ai = 0; ai < 2; ++ai)
#pragma unroll
            for (int m = 0; m < 4; ++m) sv[ai][m] = __hip_atomic_load(SS2 + row0 + ai * HALF + m * 16, __ATOMIC_RELAXED, __HIP_MEMORY_SCOPE_AGENT);
#pragma unroll
        for (int ai = 0; ai < 2; ++ai)
#pragma unroll
            for (int m = 0; m < 4; ++m) { const int row = row0 + ai * HALF + m * 16; float* rowp = OUT + (size_t)row * 1024 + col0;
                const float s = sv[ai][m]; const float rstd = 1.0f / sqrtf(s * (1.0f / 1024.0f) + 1e-6f);
#pragma unroll
                for (int bj = 0; bj < 2; ++bj)
#pragma unroll
                    for (int n = 0; n < 2; ++n) st_nt((f32x4*)(rowp + bj * HALF + n * 16), acc[ai][bj][m][n] * rstd * gv[bj][n]); }
    }
};

struct EpiDry {
    static constexpr bool PERM = true, AFTER_DRAIN = false, HAS_MID = false; static constexpr int AUX_A = 0;
    float* SINK;
    __device__ __forceinline__ void operator()(const f32x4 (&acc)[2][2][4][2], const Unit& u, int wr, int wc, int fr, int fq) const {
        f32x4 s = (f32x4){0.f, 0.f, 0.f, 0.f};
#pragma unroll
        for (int ai = 0; ai < 2; ++ai)
#pragma unroll
            for (int bj = 0; bj < 2; ++bj)
#pragma unroll
                for (int m = 0; m < 4; ++m)
#pragma unroll
                    for (int n = 0; n < 2; ++n) s += acc[ai][bj][m][n];
        if (s[0] + s[1] + s[2] + s[3] == 1.2345e33f) SINK[0] = s[0];
    }
};
template <class Epi, class Sched, bool ALIGN_EPI = false, bool SP2 = false>
__device__ __forceinline__ void gemm_phase(PG8_LAS unsigned char* lds, const Gemm g, const Sched& S, const Epi& E) {
    const int tid = threadIdx.x, wid = __builtin_amdgcn_readfirstlane(tid >> 6), lane = tid & 63, wr = wid >> 2, wc = wid & 3, fr = lane & 15, fq = lane >> 4;
    const int K = g.K, nt = K / BK, LD = g.ld ? g.ld : g.K, skt = g.split_kt ? g.split_kt : (1 << 30);
    unsigned voffA[2], voffB[2];
#pragma unroll
    for (int i = 0; i < 2; ++i) { int R, C; stage_rc(tid * 16 + i * 8192, R, C); const int Rb = Epi::PERM ? ((R & ~31) + perm32(R & 31)) : R;
        voffA[i] = (unsigned)(R * LD + C) * 2u; voffB[i] = (unsigned)(Rb * LD + C) * 2u; }
    const size_t kstep = (size_t)(BK * 2);
    const long adjA = g.splitA - (long)g.split_kt * (BK * 2), adjB = g.splitB - (long)g.split_kt * (BK * 2);
    const size_t hstep = (size_t)HALF * LD * 2;
    const size_t tstep = 2 * hstep;
    const unsigned ldsw = (unsigned)wid * 1024u;
    const int aoff = lds_byte(wr * 64 + fr, fq * 8), boff = lds_byte(wc * 32 + fr, fq * 8);
#define PG8_SA(b, h) (((b) * 2 + (h)) * HTB)
#define PG8_SB(b, h) ((4 + (b) * 2 + (h)) * HTB)
#define PG8_STAGE(bufoff, gbase, voff) do { _Pragma("unroll") for (int _i = 0; _i < 2; ++_i) \
        __builtin_amdgcn_global_load_lds((const unsigned*)((const char*)(gbase) + (voff)[_i]), (PG8_LAS unsigned*)(lds + (bufoff) + ldsw + _i * 8192), 16, 0, 0); } while (0)
#define PG8_LDA(dst, b, h) do { _Pragma("unroll") for (int m = 0; m < 4; ++m) _Pragma("unroll") for (int k = 0; k < 2; ++k) dst[m][k] = *(const PG8_LAS bf16x8*)(lds + PG8_SA(b, h) + aoff + m * 2048 + k * 1024); } while (0)
#define PG8_LDB(dst, b, h) do { _Pragma("unroll") for (int n = 0; n < 2; ++n) _Pragma("unroll") for (int k = 0; k < 2; ++k) dst[n][k] = *(const PG8_LAS bf16x8*)(lds + PG8_SB(b, h) + boff + n * 2048 + k * 1024); } while (0)
#define PG8_MMA(ai, bj, At, Bt) do { __builtin_amdgcn_s_setprio(1); _Pragma("unroll") for (int m = 0; m < 4; ++m) _Pragma("unroll") for (int n = 0; n < 2; ++n) _Pragma("unroll") for (int k = 0; k < 2; ++k) \
        acc[ai][bj][m][n] = __builtin_amdgcn_mfma_f32_16x16x32_bf16(Bt[n][k], At[m][k], acc[ai][bj][m][n], 0, 0, 0); __builtin_amdgcn_s_setprio(0); } while (0)
#define PG8_WAIT_V(n) asm volatile("s_waitcnt vmcnt(" #n ")" ::: "memory")
#define PG8_WAIT_L(n) asm volatile("s_waitcnt lgkmcnt(" #n ")" ::: "memory")
#define PG8_BAR __builtin_amdgcn_s_barrier()
#define PG8_SCHED __builtin_amdgcn_sched_barrier(0)
    Unit cur, nxt; int ui = 0;
    if (!S.next(0, cur)) return;
    f32x4 acc[2][2][4][2];
#pragma unroll
    for (int a = 0; a < 2; ++a)
#pragma unroll
        for (int b = 0; b < 2; ++b)
#pragma unroll
            for (int m = 0; m < 4; ++m)
#pragma unroll
                for (int n = 0; n < 2; ++n) acc[a][b][m][n] = (f32x4){0.f, 0.f, 0.f, 0.f};
    bf16x8 At[4][2], B0[2][2], B1[2][2];
    const char* cA = (const char*)g.A + (size_t)cur.pm * tstep; const char* cB = (const char*)g.Bt + (size_t)cur.pn * tstep;
    S.a_ready(cur);
    if constexpr (SP2) {
        PG8_STAGE(PG8_SB(0, 0), cB, voffB); PG8_STAGE(PG8_SB(0, 1), cB + hstep, voffB); PG8_STAGE(PG8_SA(0, 0), cA, voffA); PG8_STAGE(PG8_SA(0, 1), cA + hstep, voffA);
        if (wr == 1) PG8_BAR;
        PG8_WAIT_V(2); PG8_BAR;
        PG8_STAGE(PG8_SB(1, 0), cB + kstep, voffB); PG8_STAGE(PG8_SA(1, 0), cA + kstep, voffA); PG8_STAGE(PG8_SB(1, 1), cB + hstep + kstep, voffB);
        PG8_WAIT_V(6); PG8_BAR;
    } else {
        PG8_STAGE(PG8_SB(0, 0), cB, voffB); PG8_STAGE(PG8_SA(0, 0), cA, voffA); PG8_STAGE(PG8_SB(0, 1), cB + hstep, voffB); PG8_STAGE(PG8_SA(0, 1), cA + hstep, voffA);
        if (wr == 1) PG8_BAR;
        PG8_WAIT_V(4); PG8_BAR;
        PG8_STAGE(PG8_SB(1, 0), cB + kstep, voffB); PG8_STAGE(PG8_SA(1, 0), cA + kstep, voffA); PG8_STAGE(PG8_SB(1, 1), cB + hstep + kstep, voffB);
        PG8_WAIT_V(6); PG8_BAR;
    }
    for (;;) {
        const bool has_next = S.next(ui + 1, nxt);
        const char* nA = has_next ? (const char*)g.A + (size_t)nxt.pm * tstep : cA; const char* nB = has_next ? (const char*)g.Bt + (size_t)nxt.pn * tstep : cB;
        for (int t = 0; t < nt; t += 2) {
            const bool last = (t == nt - 2);
            const char* a1 = cA + (size_t)(t + 1) * kstep + (t + 1 >= skt ? adjA : 0);
            const char* a2 = last ? nA : cA + (size_t)(t + 2) * kstep + (t + 2 >= skt ? adjA : 0); const char* b2 = last ? nB : cB + (size_t)(t + 2) * kstep + (t + 2 >= skt ? adjB : 0);
            if constexpr (Epi::HAS_MID) { if (t == skt) E.mid(acc, cur, wr, wc, fr, fq); }
            const char* a3 = a2 + kstep; const char* b3 = b2 + kstep;
            if (last && has_next) S.a_ready(nxt);
            if constexpr (SP2) {
            PG8_LDB(B0, 0, 0); PG8_LDB(B1, 0, 1); PG8_SCHED; PG8_LDA(At, 0, 0); PG8_STAGE(PG8_SA(1, 1), a1 + hstep, voffA);
            PG8_WAIT_V(8); PG8_WAIT_L(0); PG8_BAR; PG8_MMA(0, 0, At, B0); PG8_MMA(0, 1, At, B1); PG8_BAR; PG8_SCHED;
            PG8_LDA(At, 0, 1); PG8_STAGE(PG8_SB(0, 0), b2, voffB); PG8_STAGE(PG8_SB(0, 1), b2 + hstep, voffB); PG8_STAGE(PG8_SA(0, 0), a2, voffA);
            PG8_WAIT_V(8); PG8_WAIT_L(0); PG8_BAR; PG8_MMA(1, 0, At, B0); PG8_MMA(1, 1, At, B1); PG8_BAR; PG8_SCHED;
            PG8_LDB(B0, 1, 0); PG8_LDB(B1, 1, 1); PG8_SCHED; PG8_LDA(At, 1, 0); PG8_STAGE(PG8_SA(0, 1), a2 + hstep, voffA);
            PG8_WAIT_V(8); PG8_WAIT_L(0); PG8_BAR; PG8_MMA(0, 0, At, B0); PG8_MMA(0, 1, At, B1); PG8_BAR; PG8_SCHED;
            PG8_LDA(At, 1, 1); PG8_STAGE(PG8_SB(1, 0), b3, voffB); PG8_STAGE(PG8_SB(1, 1), b3 + hstep, voffB); PG8_STAGE(PG8_SA(1, 0), a3, voffA);
            PG8_WAIT_V(8); PG8_WAIT_L(0); PG8_BAR; PG8_MMA(1, 0, At, B0); PG8_MMA(1, 1, At, B1); PG8_BAR; PG8_SCHED;
            } else {
            PG8_LDB(B0, 0, 0); PG8_SCHED; PG8_LDA(At, 0, 0); PG8_STAGE(PG8_SA(1, 1), a1 + hstep, voffA);
            PG8_WAIT_L(8); PG8_BAR; PG8_WAIT_L(0); PG8_MMA(0, 0, At, B0); PG8_BAR; PG8_SCHED;
            PG8_LDB(B1, 0, 1); PG8_STAGE(PG8_SB(0, 0), b2, voffB);
            PG8_BAR; PG8_WAIT_L(0); PG8_MMA(0, 1, At, B1); PG8_BAR;
            PG8_LDA(At, 0, 1); PG8_STAGE(PG8_SA(0, 0), a2, voffA);
            PG8_BAR; PG8_WAIT_L(0); PG8_MMA(1, 0, At, B0); PG8_BAR; PG8_SCHED;
            PG8_STAGE(PG8_SB(0, 1), b2 + hstep, voffB);
            PG8_WAIT_V(6); PG8_BAR; PG8_MMA(1, 1, At, B1); PG8_BAR;
            PG8_LDB(B0, 1, 0); PG8_SCHED; PG8_LDA(At, 1, 0); PG8_STAGE(PG8_SA(0, 1), a2 + hstep, voffA);
            PG8_WAIT_L(8); PG8_BAR; PG8_WAIT_L(0); PG8_MMA(0, 0, At, B0); PG8_BAR; PG8_SCHED;
            PG8_LDB(B1, 1, 1); PG8_STAGE(PG8_SB(1, 0), b3, voffB);
            PG8_BAR; PG8_WAIT_L(0); PG8_MMA(0, 1, At, B1); PG8_BAR;
            PG8_LDA(At, 1, 1); PG8_STAGE(PG8_SA(1, 0), a3, voffA);
            PG8_BAR; PG8_WAIT_L(0); PG8_MMA(1, 0, At, B0); PG8_BAR; PG8_SCHED;
            PG8_STAGE(PG8_SB(1, 1), b3 + hstep, voffB);
            PG8_WAIT_V(6); PG8_BAR; PG8_MMA(1, 1, At, B1); PG8_BAR;
            }
        }
        if constexpr (ALIGN_EPI) { if (wr == 0) PG8_BAR; }
        if constexpr (!Epi::AFTER_DRAIN) { E(acc, cur, wr, wc, fr, fq); S.done(cur); }
        if (!has_next) break;
#pragma unroll
        for (int a = 0; a < 2; ++a)
#pragma unroll
            for (int b = 0; b < 2; ++b)
#pragma unroll
                for (int m = 0; m < 4; ++m)
#pragma unroll
                    for (int n = 0; n < 2; ++n) acc[a][b][m][n] = (f32x4){0.f, 0.f, 0.f, 0.f};
        cur = nxt; cA = nA; cB = nB; ++ui;
        if constexpr (ALIGN_EPI) { if (wr == 1) PG8_BAR; }
    }
    PG8_WAIT_V(0);
    if constexpr (!ALIGN_EPI) { if (wr == 0) PG8_BAR; }
    PG8_BAR;
    if constexpr (Epi::AFTER_DRAIN) { E.fused(acc, cur, wr, wc, fr, fq, lds, wid, lane); S.done(cur); }
#undef PG8_SA
#undef PG8_SB
#undef PG8_STAGE
#undef PG8_LDA
#undef PG8_LDB
#undef PG8_MMA
#undef PG8_WAIT_V
#undef PG8_WAIT_L
#undef PG8_BAR
#undef PG8_SCHED
}
}

#ifndef MK_N_LAUNCHES
#define MK_N_LAUNCHES 1
#endif
namespace cg = cooperative_groups;
#define LAS __attribute__((address_space(3)))
#define DI __device__ __forceinline__
typedef unsigned short bf16;
typedef float f32x4 __attribute__((ext_vector_type(4)));
typedef float f32x2 __attribute__((ext_vector_type(2)));
typedef short bf16x8 __attribute__((ext_vector_type(8)));
typedef unsigned u32x4 __attribute__((ext_vector_type(4)));
typedef unsigned u32x2 __attribute__((ext_vector_type(2)));

constexpr int T = 32768, D = 1024, SEQ = 8192, DIN = 8192, FF = 4096;
constexpr float EPS = 1e-6f;
constexpr int NPHASES = 8;
constexpr int LDS_MISC = 131072;
constexpr int LDS_BYTES = 139264;

constexpr size_t MiB = 1u << 20;
constexpr size_t WS_WIN = 0;
constexpr size_t WS_L   = 0;
constexpr size_t WS_WA  = 16 * MiB;
constexpr size_t WS_WB  = 18 * MiB;
constexpr size_t WS_WO  = 20 * MiB;
constexpr size_t WS_WMI = 22 * MiB;
constexpr size_t WS_WMO = 30 * MiB;
constexpr size_t WS_SS  = 38 * MiB;
constexpr size_t WS_LB  = 40 * MiB;
constexpr size_t WS_DSEG = 40 * MiB + 65536;
constexpr size_t WS_CTL = 41 * MiB, CTL_CNT = 16384, CTL_SS2 = 65536, CTL_BYTES = 196608;
constexpr size_t WS_RINV = 42 * MiB;
constexpr size_t WS_END = 512 * MiB;
constexpr size_t SLOT = 64 * MiB;
constexpr size_t S_V = 1 * SLOT, S_U = 2 * SLOT, S_H = 3 * SLOT, S_LF = 4 * SLOT, S_GS = 5 * SLOT, S_GA = 6 * SLOT, S_GB = 7 * SLOT;
constexpr size_t S_X1B = S_V, S_OA = S_U, S_UB = S_H, S_MG = S_LF, S_ZZ = 2 * SLOT;

struct Args { const float* in[16]; float* out; unsigned char* ws; int ph_lo, ph_hi, sync_mode, pad; };

DI float wave_sum(float v) {
#pragma unroll
    for (int o = 1; o < 64; o <<= 1) v += __shfl_xor(v, o);
    return v;
}
DI unsigned f2bf(float f) { unsigned u = __builtin_bit_cast(unsigned, f); return (u + 0x7fffu + ((u >> 16) & 1u)) >> 16; }
typedef __bf16 bf16x2_t __attribute__((ext_vector_type(2)));
DI unsigned pk2(float lo, float hi) { f32x2 v = {lo, hi}; bf16x2_t b = __builtin_convertvector(v, bf16x2_t); return __builtin_bit_cast(unsigned, b); }
DI float bflo(unsigned w) { return __uint_as_float(w << 16); }
DI float bfhi(unsigned w) { return __uint_as_float(w & 0xffff0000u); }
DI float ex2(float x) { return __builtin_amdgcn_exp2f(x); }

DI void p0_transpose_item(const float* W, int K, int N, bf16* WT, int k0, int n0, int src_n0, const float* kscale, LAS float* scr, int lane) {
    float wv[32];
#pragma unroll
    for (int i = 0; i < 32; ++i) wv[i] = __builtin_nontemporal_load(W + (size_t)(k0 + 2 * i + (lane >> 5)) * N + src_n0 + (lane & 31));
#pragma unroll
    for (int i = 0; i < 32; ++i) { const int kk = 2 * i + (lane >> 5); float v = wv[i]; if (kscale) v *= kscale[k0 + kk]; scr[kk * 33 + (lane & 31)] = v; }
    asm volatile("s_waitcnt lgkmcnt(0)" ::: "memory");
    const int c = lane & 7;
#pragma unroll
    for (int j = 0; j < 4; ++j) { const int n = (lane >> 3) + 8 * j; const LAS float* s = scr + (8 * c) * 33 + n;
        u32x4 o; o.x = pk2(s[0 * 33], s[1 * 33]); o.y = pk2(s[2 * 33], s[3 * 33]); o.z = pk2(s[4 * 33], s[5 * 33]); o.w = pk2(s[6 * 33], s[7 * 33]);
        *(u32x4*)(WT + (size_t)(n0 + n) * K + k0 + 8 * c) = o; }
    asm volatile("s_waitcnt lgkmcnt(0)" ::: "memory");
}
DI void p0_matrix(const float* W, int K, int N, bf16* WT, const float* kscale, bool glu, LAS float* scr, int gw, int ngw, int lane) {
    const int nblk = N / 32, items = (K / 64) * nblk;
    for (int it = gw; it < items; it += ngw) { const int kb = it / nblk, nb = it % nblk; const int n0 = nb * 32; int src = n0;
        if (glu) {
            const int tile = n0 >> 8, r = n0 & 255;
            if (tile < 4) src = n0;
            else if (tile < 8) src = 3072 + (n0 - 1024);
            else if (tile < 12) src = 1024 + (n0 - 2048);
            else if (tile < 16) src = 4096 + (r >> 7) * 1024 + 128 * (tile - 12) + (r & 127);
            else if (tile < 20) src = 2048 + (n0 - 4096);
            else if (tile < 24) src = 4096 + (r >> 7) * 1024 + 128 * (tile - 20 + 4) + (r & 127);
            else src = 6144 + (r >> 7) * 1024 + 128 * (tile - 24) + (r & 127); }
        p0_transpose_item(W, K, N, WT, kb * 64, n0, src, kscale, scr, lane); }
}
DI void p0_prologue(const Args& a, LAS unsigned char* lds, int G, int tid, int lane, int wave) {
    LAS float* scr = (LAS float*)(lds + wave * 16384);
    const int gw = blockIdx.x * 8 + wave, ngw = G * 8;
    unsigned char* ws = a.ws;
    p0_matrix(a.in[2], D, DIN, (bf16*)(ws + WS_WIN), nullptr, true, scr, gw, ngw, lane);
    if (blockIdx.x == 0) { const float* lp = a.in[3]; float* LB = (float*)(ws + WS_LB);
        for (int c = tid; c < 1024; c += 512) LB[c] = 1.0f / (1.0f + __expf(lp[1024 + c] - lp[c])); }
    const float* x = a.in[0]; const float* g1 = a.in[1]; bf16* H = (bf16*)(ws + S_H);
    f32x4 gv[4];
#pragma unroll
    for (int j = 0; j < 4; ++j) gv[j] = *(const f32x4*)(g1 + 4 * lane + 256 * j);
    f32x4 nxv[4], nyv[4];
    if (gw < T) {
#pragma unroll
        for (int j = 0; j < 4; ++j) nxv[j] = __builtin_nontemporal_load((const f32x4*)(x + (size_t)gw * D) + lane + 64 * j); }
    if (gw + ngw < T) {
#pragma unroll
        for (int j = 0; j < 4; ++j) nyv[j] = __builtin_nontemporal_load((const f32x4*)(x + (size_t)(gw + ngw) * D) + lane + 64 * j); }
    for (int m = gw; m < T; m += ngw) { f32x4 v[4]; float s = 0.f;
#pragma unroll
        for (int j = 0; j < 4; ++j) { v[j] = nxv[j]; nxv[j] = nyv[j]; }
        if (m + 2 * ngw < T) {
#pragma unroll
            for (int j = 0; j < 4; ++j) nyv[j] = __builtin_nontemporal_load((const f32x4*)(x + (size_t)(m + 2 * ngw) * D) + lane + 64 * j); }
#pragma unroll
        for (int j = 0; j < 4; ++j) s += (v[j].x * v[j].x + v[j].y * v[j].y) + (v[j].z * v[j].z + v[j].w * v[j].w);
        const float rms = sqrtf(wave_sum(s) * (1.0f / D) + EPS), rstd = 1.0f / rms; if (lane == 0) ((float*)(ws + WS_RINV))[m] = rms;
        u32x2* o = (u32x2*)(H + (size_t)m * D) + lane;
#pragma unroll
        for (int j = 0; j < 4; ++j) { u32x2 w; w.x = pk2(v[j].x * rstd * gv[j].x, v[j].y * rstd * gv[j].y); w.y = pk2(v[j].z * rstd * gv[j].z, v[j].w * rstd * gv[j].w); o[64 * j] = w; } }
}

DI void late_weights(const Args& a, LAS unsigned char* lds, int G, int lane, int wave) {
    LAS float* scr = (LAS float*)(lds + wave * 16384);
    const int gw = blockIdx.x * 8 + wave, ngw = G * 8;
    unsigned char* ws = a.ws;
    p0_matrix(a.in[5], D, D, (bf16*)(ws + WS_WA), nullptr, false, scr, gw, ngw, lane);
    p0_matrix(a.in[10], D, D, (bf16*)(ws + WS_WB), nullptr, false, scr, gw, ngw, lane);
    p0_matrix(a.in[11], D, D, (bf16*)(ws + WS_WO), nullptr, false, scr, gw, ngw, lane);
    p0_matrix(a.in[13], D, FF, (bf16*)(ws + WS_WMI), a.in[12], false, scr, gw, ngw, lane);
    p0_matrix(a.in[14], FF, D, (bf16*)(ws + WS_WMO), nullptr, false, scr, gw, ngw, lane);
}

constexpr int HQ_QT = 0, HQ_KT = 17408, HQ_KDT = 34816, HQ_VT = 53248, HQ_PP = 71680, HQ_ST = 80896, HQ_TOT = 115712, HQ_DV = 119808, HQ_SSQ = 120320;
constexpr int PA = 272, PB = 144;
DI bf16x8 ldfrag(const LAS unsigned char* base, int pitch, int row0, int k0, int lane) {
    return *(const LAS bf16x8*)(base + (row0 + (lane & 15)) * pitch + (k0 + 8 * (lane >> 4)) * 2);
}
#define MFMA16(a, b, c) __builtin_amdgcn_mfma_f32_16x16x32_bf16((a), (b), (c), 0, 0, 0)

template <bool PASS2>
DI void hgrn_unit(LAS unsigned char* lds, const Args& a, int unit, int tid, int lane, int w) {
    unsigned char* ws = a.ws;
    const bf16* Qb = (const bf16*)a.out;
    const bf16* Vb = (const bf16*)(ws + S_V); const bf16* LFb = (const bf16*)(ws + S_LF); const bf16* GSb = (const bf16*)(ws + S_GS); bf16* OA = (bf16*)(ws + S_OA);
    float* Lst = (float*)(ws + WS_L); float* DSEG = (float*)(ws + WS_DSEG); const float* HG = a.in[4];
    const int bh = unit >> 3, seg = unit & 7, b = bh >> 3, h = bh & 7;
    const size_t tok0 = (size_t)b * SEQ + (size_t)seg * 1024; const int cb = h * 128;
    const int fr = lane & 15, fq = lane >> 4;
    LAS float* TOT = (LAS float*)(lds + HQ_TOT); LAS float* DV = (LAS float*)(lds + HQ_DV); LAS float* SSQ = (LAS float*)(lds + HQ_SSQ);
    f32x4 S[8];
#pragma unroll
    for (int n = 0; n < 8; ++n) S[n] = (f32x4){0.f, 0.f, 0.f, 0.f};
    float segtot0 = 0.f, segtot1 = 0.f;
    const f32x2 lbv = *(const f32x2*)((const float*)(ws + WS_LB) + cb + 2 * lane); const f32x2 omlv = (f32x2){1.0f - lbv.x, 1.0f - lbv.y};
    f32x2 gh = (f32x2){1.f, 1.f};
    if (PASS2) {
        gh = *(const f32x2*)(HG + 2 * lane);
        float Lr[32], Dr[4];
#define HG_LLOAD(ii) do { const float* Li_ = Lst + (size_t)(bh * 8 + (ii)) * 16384 + (16 * w + 4 * fq) * 128 + fr; const float* Di_ = DSEG + (bh * 8 + (ii)) * 128 + 16 * w + 4 * fq; \
            _Pragma("unroll") for (int r = 0; r < 4; ++r) Dr[r] = Di_[r]; \
            _Pragma("unroll") for (int n = 0; n < 8; ++n) _Pragma("unroll") for (int r = 0; r < 4; ++r) Lr[n * 4 + r] = Li_[r * 128 + 16 * n]; } while (0)
        if (seg > 0) HG_LLOAD(0);
        for (int i = 0; i < seg; ++i) { float Lc[32], dd[4];
#pragma unroll
            for (int r = 0; r < 4; ++r) dd[r] = ex2(Dr[r]);
#pragma unroll
            for (int k = 0; k < 32; ++k) Lc[k] = Lr[k];
            if (i + 1 < seg) HG_LLOAD(i + 1);
#pragma unroll
            for (int n = 0; n < 8; ++n)
#pragma unroll
                for (int r = 0; r < 4; ++r) S[n][r] = S[n][r] * dd[r] + Lc[n * 4 + r]; }
#undef HG_LLOAD
#pragma unroll
        for (int n = 0; n < 8; ++n) { u32x2 pk; pk.x = pk2(S[n][0], S[n][1]); pk.y = pk2(S[n][2], S[n][3]); *(LAS u32x2*)(lds + HQ_ST + (16 * n + fr) * PA + (16 * w + 4 * fq) * 2) = pk; }
    }
    unsigned nlf[8], nv[8], nq[8], ngs[8];
#define HG_LOAD(cc) do { const size_t rb_ = tok0 + (size_t)(cc) * 64 + 8 * w; _Pragma("unroll") for (int i = 0; i < 8; ++i) { const size_t off = (rb_ + i) * D + cb + 2 * lane; \
            nlf[i] = *(const unsigned*)(LFb + off); nv[i] = *(const unsigned*)(Vb + off); if (PASS2) { nq[i] = *(const unsigned*)(Qb + off); ngs[i] = *(const unsigned*)(GSb + off); } } } while (0)
    HG_LOAD(0);
    for (int c = 0; c < 16; ++c) {
        unsigned vr[8], qr[8], gsc[8];
#pragma unroll
        for (int i = 0; i < 8; ++i) { vr[i] = nv[i]; if (PASS2) { qr[i] = nq[i]; gsc[i] = ngs[i]; } }
        f32x2 pl[8], kf[8]; f32x2 run = (f32x2){1.f, 1.f};
#pragma unroll
        for (int i = 0; i < 8; ++i) { const pg8::f16x2 hv = __builtin_bit_cast(pg8::f16x2, nlf[i]); const f32x2 s2 = (f32x2){(float)hv.x, (float)hv.y};
            run = run * (lbv + omlv * s2); pl[i] = run; kf[i] = omlv - omlv * s2; }
        *(LAS f32x2*)(TOT + w * 128 + 2 * lane) = run;
        __syncthreads();
        f32x2 pre = (f32x2){1.f, 1.f}, tot = (f32x2){1.f, 1.f};
#pragma unroll
        for (int ww = 0; ww < 8; ++ww) { const f32x2 t = *(const LAS f32x2*)(TOT + ww * 128 + 2 * lane); tot = tot * t; if (ww < w) pre = pre * t; }
        segtot0 += __builtin_amdgcn_logf(tot.x); segtot1 += __builtin_amdgcn_logf(tot.y);
        unsigned kd0[4], kd1[4];
#pragma unroll
        for (int i = 0; i < 8; i += 2) {
            f32x2 kd[2];
#pragma unroll
            for (int e = 0; e < 2; ++e) { const int ii = i + e; f32x2 E = pre * pl[ii]; E.x = fmaxf(E.x, 2.4e-35f); E.y = fmaxf(E.y, 2.4e-35f);
                const f32x2 inv = (f32x2){__builtin_amdgcn_rcpf(E.x), __builtin_amdgcn_rcpf(E.y)}; const f32x2 kt = kf[ii] * inv; kd[e] = kt * tot;
                if (PASS2) { const f32x2 q2 = (f32x2){bflo(qr[ii]), bfhi(qr[ii])} * E;
                    *(LAS unsigned*)(lds + HQ_QT + (8 * w + ii) * PA + 4 * lane) = pk2(q2.x, q2.y);
                    *(LAS unsigned*)(lds + HQ_KT + (8 * w + ii) * PA + 4 * lane) = pk2(kt.x, kt.y); } }
            kd0[i >> 1] = pk2(kd[0].x, kd[1].x); kd1[i >> 1] = pk2(kd[0].y, kd[1].y); }
        *(LAS u32x4*)(lds + HQ_KDT + (2 * lane) * PB + 16 * w) = (u32x4){kd0[0], kd0[1], kd0[2], kd0[3]};
        *(LAS u32x4*)(lds + HQ_KDT + (2 * lane + 1) * PB + 16 * w) = (u32x4){kd1[0], kd1[1], kd1[2], kd1[3]};
        { u32x4 v0, v1;
          v0.x = (vr[0] & 0xffffu) | (vr[1] << 16); v0.y = (vr[2] & 0xffffu) | (vr[3] << 16); v0.z = (vr[4] & 0xffffu) | (vr[5] << 16); v0.w = (vr[6] & 0xffffu) | (vr[7] << 16);
          v1.x = (vr[0] >> 16) | (vr[1] & 0xffff0000u); v1.y = (vr[2] >> 16) | (vr[3] & 0xffff0000u); v1.z = (vr[4] >> 16) | (vr[5] & 0xffff0000u); v1.w = (vr[6] >> 16) | (vr[7] & 0xffff0000u);
          *(LAS u32x4*)(lds + HQ_VT + (2 * lane) * PB + 16 * w) = v0; *(LAS u32x4*)(lds + HQ_VT + (2 * lane + 1) * PB + 16 * w) = v1; }
        if (w == 0) *(LAS f32x2*)(DV + 2 * lane) = tot;
        __syncthreads();
        if (c < 15) HG_LOAD(c + 1);
        if (PASS2) {
            const int tt = w & 3;
#pragma unroll
            for (int e = 0; e < 2; ++e) { const int st = 2 * (w >> 2) + e; f32x4 sc = (f32x4){0.f, 0.f, 0.f, 0.f};
                if (st <= tt) {
#pragma unroll
                    for (int ks = 0; ks < 4; ++ks) sc = MFMA16(ldfrag(lds + HQ_KT, PA, 16 * st, 32 * ks, lane), ldfrag(lds + HQ_QT, PA, 16 * tt, 32 * ks, lane), sc); }
                const int t = 16 * tt + fr, s0 = 16 * st + 4 * fq;
#pragma unroll
                for (int r = 0; r < 4; ++r) if (s0 + r > t) sc[r] = 0.f;
                u32x2 pk; pk.x = pk2(sc[0], sc[1]); pk.y = pk2(sc[2], sc[3]);
                *(LAS u32x2*)(lds + HQ_PP + t * PB + s0 * 2) = pk; }
            __syncthreads();
            const int mt = w & 3; f32x4 o[4];
#pragma unroll
            for (int j = 0; j < 4; ++j) o[j] = (f32x4){0.f, 0.f, 0.f, 0.f};
#pragma unroll
            for (int ks = 0; ks < 4; ++ks) { const bf16x8 bq = ldfrag(lds + HQ_QT, PA, 16 * mt, 32 * ks, lane);
#pragma unroll
                for (int j = 0; j < 4; ++j) o[j] = MFMA16(ldfrag(lds + HQ_ST, PA, 16 * (4 * (w >> 2) + j), 32 * ks, lane), bq, o[j]); }
#pragma unroll
            for (int ks = 0; ks < 2; ++ks) { const bf16x8 bp = ldfrag(lds + HQ_PP, PB, 16 * mt, 32 * ks, lane);
#pragma unroll
                for (int j = 0; j < 4; ++j) o[j] = MFMA16(ldfrag(lds + HQ_VT, PB, 16 * (4 * (w >> 2) + j), 32 * ks, lane), bp, o[j]); }
            float q = 0.f;
#pragma unroll
            for (int j = 0; j < 4; ++j) q += (o[j][0] * o[j][0] + o[j][1] * o[j][1]) + (o[j][2] * o[j][2] + o[j][3] * o[j][3]);
            q += __shfl_xor(q, 16); q += __shfl_xor(q, 32);
            if (fq == 0) SSQ[(16 * mt + fr) * 2 + (w >> 2)] = q;
            __syncthreads();
            { const f32x2 s2 = *(const LAS f32x2*)(SSQ + (16 * mt + fr) * 2); const float rstd = __builtin_amdgcn_rsqf((s2.x + s2.y) * (1.0f / 128.0f) + EPS);
#pragma unroll
              for (int j = 0; j < 4; ++j) { u32x2 pk; pk.x = pk2(o[j][0] * rstd, o[j][1] * rstd); pk.y = pk2(o[j][2] * rstd, o[j][3] * rstd);
                  *(LAS u32x2*)(lds + HQ_KT + (16 * mt + fr) * PA + (16 * (4 * (w >> 2) + j) + 4 * fq) * 2) = pk; } }
            __syncthreads();
#pragma unroll
            for (int i = 0; i < 8; ++i) { const unsigned ot = *(const LAS unsigned*)(lds + HQ_KT + (8 * w + i) * PA + 4 * lane);
                *(unsigned*)(OA + (tok0 + (size_t)c * 64 + 8 * w + i) * D + cb + 2 * lane) = pk2(bflo(ot) * gh.x * bflo(gsc[i]), bfhi(ot) * gh.y * bfhi(gsc[i])); }
        }
        { float dd[4];
#pragma unroll
          for (int r = 0; r < 4; ++r) dd[r] = DV[16 * w + 4 * fq + r];
          const bf16x8 a0 = ldfrag(lds + HQ_KDT, PB, 16 * w, 0, lane), a1 = ldfrag(lds + HQ_KDT, PB, 16 * w, 32, lane);
#pragma unroll
          for (int n = 0; n < 8; ++n) {
#pragma unroll
              for (int r = 0; r < 4; ++r) S[n][r] *= dd[r];
              S[n] = MFMA16(a0, ldfrag(lds + HQ_VT, PB, 16 * n, 0, lane), S[n]); S[n] = MFMA16(a1, ldfrag(lds + HQ_VT, PB, 16 * n, 32, lane), S[n]); }
          if (PASS2) {
#pragma unroll
              for (int n = 0; n < 8; ++n) { u32x2 pk; pk.x = pk2(S[n][0], S[n][1]); pk.y = pk2(S[n][2], S[n][3]); *(LAS u32x2*)(lds + HQ_ST + (16 * n + fr) * PA + (16 * w + 4 * fq) * 2) = pk; } }
        }
    }
    if (!PASS2) { float* Lu = Lst + (size_t)unit * 16384;
#pragma unroll
        for (int n = 0; n < 8; ++n)
#pragma unroll
            for (int r = 0; r < 4; ++r) Lu[(16 * w + 4 * fq + r) * 128 + 16 * n + fr] = S[n][r];
        if (w == 0) *(f32x2*)(DSEG + unit * 128 + 2 * lane) = (f32x2){segtot0, segtot1}; }
    __syncthreads();
#undef HG_LOAD
}

DI void conv_tile(LAS unsigned char* lds, const Args& a, int tile, int tid, int lane, int w) {
    unsigned char* ws = a.ws; const bf16* U = (const bf16*)(ws + S_U); bf16* UB = (bf16*)a.out + (size_t)T * D;
    const float *CW = a.in[6], *CBs = a.in[7], *LG = a.in[8], *LBt = a.in[9];
    const int t0 = tile * 128, pos0 = t0 & (SEQ - 1), c2 = 2 * tid;
    LAS float* RED = (LAS float*)lds;
    f32x2 wreg[31];
    const float* cwp = CW + c2; asm volatile("" : "+v"(cwp));
#pragma unroll
    for (int j = 0; j < 31; ++j) wreg[j] = *(const f32x2*)(cwp + j * 1024);
    const f32x2 bias = *(const f32x2*)(CBs + c2), lng = *(const f32x2*)(LG + c2), lnb = *(const f32x2*)(LBt + c2);
    f32x2 win[34];
#pragma unroll
    for (int i = 0; i < 30; ++i) { unsigned wv = 0u; if (pos0 + i - 30 >= 0) wv = *(const unsigned*)(U + (size_t)(t0 + i - 30) * D + c2); win[i] = (f32x2){bflo(wv), bfhi(wv)}; }
    unsigned nx[16];
#pragma unroll
    for (int i = 0; i < 16; ++i) nx[i] = *(const unsigned*)(U + (size_t)(t0 + i) * D + c2);
    for (int g4 = 0; g4 < 8; ++g4)
#pragma unroll
    for (int gg = 0; gg < 4; ++gg) { const int g = g4 * 4 + gg;
#pragma unroll
        for (int i = 0; i < 4; ++i) win[30 + i] = (f32x2){bflo(nx[gg * 4 + i]), bfhi(nx[gg * 4 + i])};
        if (g4 < 7) {
#pragma unroll
            for (int i = 0; i < 4; ++i) nx[gg * 4 + i] = *(const unsigned*)(U + (size_t)(t0 + (g + 4) * 4 + i) * D + c2); }
        f32x2 y[4]; float av[8];
#pragma unroll
        for (int o = 0; o < 4; ++o) y[o] = bias;
#pragma unroll
        for (int j = 0; j < 31; ++j)
#pragma unroll
            for (int o = 0; o < 4; ++o) y[o] += wreg[j] * win[o + j];
#pragma unroll
        for (int o = 0; o < 4; ++o) { av[2 * o] = y[o].x + y[o].y; av[2 * o + 1] = y[o].x * y[o].x + y[o].y * y[o].y; }
        float dsum;
        { const bool h32 = (lane & 32) != 0, h16 = (lane & 16) != 0, h8 = (lane & 8) != 0; float b4[4], c2[2];
#pragma unroll
          for (int k = 0; k < 4; ++k) { const float snd = h32 ? av[k] : av[4 + k], kp = h32 ? av[4 + k] : av[k]; b4[k] = kp + __shfl_xor(snd, 32); }
#pragma unroll
          for (int k = 0; k < 2; ++k) { const float snd = h16 ? b4[k] : b4[2 + k], kp = h16 ? b4[2 + k] : b4[k]; c2[k] = kp + __shfl_xor(snd, 16); }
          { const float snd = h8 ? c2[0] : c2[1], kp = h8 ? c2[1] : c2[0]; dsum = kp + __shfl_xor(snd, 8); }
          dsum += __shfl_xor(dsum, 4); dsum += __shfl_xor(dsum, 2); dsum += __shfl_xor(dsum, 1); }
        LAS float* red = RED + (g & 1) * 64;
        if ((lane & 7) == 0) { const int idx = lane >> 3; red[(idx >> 1) * 16 + w * 2 + (idx & 1)] = dsum; }
        __syncthreads();
        float tot; { const int vv = lane >> 3, ww = lane & 7; tot = red[(vv >> 1) * 16 + ww * 2 + (vv & 1)]; tot += __shfl_xor(tot, 1); tot += __shfl_xor(tot, 2); tot += __shfl_xor(tot, 4); }
        const float tq = __shfl_xor(tot, 8); const float mean_l = tot * (1.0f / 1024.0f), rstd_l = __builtin_amdgcn_rsqf(fmaxf(tq * (1.0f / 1024.0f) - mean_l * mean_l, 0.f) + EPS);
#pragma unroll
        for (int o = 0; o < 4; ++o) {
            const float mean = __builtin_bit_cast(float, __builtin_amdgcn_readlane(__builtin_bit_cast(int, mean_l), 16 * o)), rstd = __builtin_bit_cast(float, __builtin_amdgcn_readlane(__builtin_bit_cast(int, rstd_l), 16 * o));
            const f32x2 yn = (y[o] - mean) * (lng * rstd) + lnb;
            const f32x2 sg = pg8::sigm2(yn), ov = yn * sg;
            *(unsigned*)(UB + (size_t)(t0 + g * 4 + o) * D + c2) = pk2(ov.x, ov.y); }
#pragma unroll
        for (int i = 0; i < 30; ++i) win[i] = win[i + 4];
    }
    __syncthreads();
}

DI void final_norm(const Args& a, int G, int lane, int wave) {
    const float* gf = a.in[15]; float* out = a.out; const int gw = blockIdx.x * 8 + wave, ngw = G * 8;
    f32x4 gv[4];
#pragma unroll
    for (int j = 0; j < 4; ++j) gv[j] = *(const f32x4*)(gf + 4 * lane + 256 * j);
    for (int m = gw; m < T; m += ngw) { f32x4* xr = (f32x4*)(out + (size_t)m * D) + lane; f32x4 v[4]; float s = 0.f;
#pragma unroll
        for (int j = 0; j < 4; ++j) { v[j] = xr[64 * j]; s += (v[j].x * v[j].x + v[j].y * v[j].y) + (v[j].z * v[j].z + v[j].w * v[j].w); }
        const float rstd = 1.0f / sqrtf(wave_sum(s) * (1.0f / D) + EPS);
#pragma unroll
        for (int j = 0; j < 4; ++j) xr[64 * j] = v[j] * rstd * gv[j]; }
}

#define XB_TMO      128
#define XB_XCNT(j)  (256  + 64 * (j))
#define XB_XSUB(j)  (1280 + 64 * (j))
#define XB_XGEN(j)  (2304 + 64 * (j))
#define XB_TOP      3328
#define XB_TOPGEN   3392
#define XCD_BAR_WORDS 3456
#define XB_SPIN_CAP (1u << 18)

__device__ __forceinline__ unsigned xb_ld(unsigned* p)              { return __hip_atomic_load(p, __ATOMIC_RELAXED, __HIP_MEMORY_SCOPE_AGENT); }
__device__ __forceinline__ unsigned xb_add(unsigned* p, unsigned v) { return __hip_atomic_fetch_add(p, v, __ATOMIC_RELAXED, __HIP_MEMORY_SCOPE_AGENT); }
__device__ __forceinline__ unsigned xb_xcc_id() { return (unsigned)__builtin_amdgcn_s_getreg((3 << 11) | 20) & 0xFu; }
#define XB_SPIN(cond, bar) do { unsigned _sp = 0; while (cond) { __builtin_amdgcn_s_sleep(1); \
    if ((++_sp & 255u) == 0u) { if (xb_ld(&(bar)[XB_TMO])) break; if (_sp > XB_SPIN_CAP) { atomicAdd(&(bar)[XB_TMO], 1u); break; } } } } while (0)

struct XcdBarrier {
    unsigned* bar; unsigned x;
    volatile LAS unsigned* st;
};

__device__ __forceinline__ XcdBarrier xcd_barrier_post(unsigned* bar, volatile LAS unsigned* st) {
    XcdBarrier b; b.bar = bar; b.x = xb_xcc_id(); b.st = st;
    if (threadIdx.x == 0) (void)xb_add(&bar[XB_XCNT(b.x)], 1u);
    return b;
}
__device__ __forceinline__ void xcd_barrier_complete(unsigned* bar, unsigned x, unsigned& nloc, unsigned& nx) {
    const unsigned G = gridDim.x * gridDim.y * gridDim.z;
    unsigned sum, cnt, mine, sp = 0u;
    for (;;) {
        sum = 0u; cnt = 0u; mine = 0u;
#pragma unroll
        for (unsigned j = 0; j < 16; ++j) { const unsigned c = xb_ld(&bar[XB_XCNT(j)]); sum += c; cnt += (c > 0u) ? 1u : 0u; mine = (j == x) ? c : mine; }
        if (sum == G) break;
        __builtin_amdgcn_s_sleep(1);
        if ((++sp & 255u) == 0u) { if (xb_ld(&bar[XB_TMO])) break; if (sp > XB_SPIN_CAP) { atomicAdd(&bar[XB_TMO], 1u); break; } }
    }
    nloc = mine > 0u ? mine : 1u; nx = cnt > 0u ? cnt : 1u;
}

__device__ __forceinline__ void xcd_barrier(const XcdBarrier& b) {
    asm volatile("s_waitcnt vmcnt(0)" ::: "memory");
    __syncthreads();
    if (threadIdx.x == 0) {
        unsigned* bar = b.bar;
        __builtin_amdgcn_s_waitcnt(0);
        unsigned nloc = b.st[0], nx = b.st[1];
        if (nloc == 0u) { xcd_barrier_complete(bar, b.x, nloc, nx); b.st[0] = nloc; b.st[1] = nx; }
        const unsigned old = xb_add(&bar[XB_XSUB(b.x)], 1u);
        const unsigned gen = old / nloc;
        if (old + 1u == (gen + 1u) * nloc) {
            __builtin_amdgcn_fence(__ATOMIC_RELEASE, "agent");
            asm volatile("s_waitcnt vmcnt(0)" ::: "memory");
            const unsigned og = xb_add(&bar[XB_TOP], 1u);
            const unsigned tg = og / nx;
            if (og + 1u == (tg + 1u) * nx) xb_add(&bar[XB_TOPGEN], 1u);
            else XB_SPIN(xb_ld(&bar[XB_TOPGEN]) == tg, bar);
            __builtin_amdgcn_fence(__ATOMIC_ACQUIRE, "agent");
            xb_add(&bar[XB_XGEN(b.x)], 1u);
            asm volatile("s_waitcnt vmcnt(0)" ::: "memory");
        } else {
            XB_SPIN(xb_ld(&bar[XB_XGEN(b.x)]) == gen, bar);
            __builtin_amdgcn_fence(__ATOMIC_ACQUIRE, "agent");
            asm volatile("s_waitcnt vmcnt(0)" ::: "memory");
        }
    }
    __syncthreads();
}

__global__ void __launch_bounds__(512, 2) fwd_megakernel(Args args) {
    extern __shared__ __attribute__((aligned(16))) unsigned char lds_raw[];
    LAS unsigned char* lds = (LAS unsigned char*)lds_raw;
    const int tid = threadIdx.x, lane = tid & 63, wave = __builtin_amdgcn_readfirstlane(tid >> 6);
    const int G = gridDim.x; unsigned char* ws = args.ws;
    const int lo = args.ph_lo, hi = args.ph_hi;
#define IN(k) (lo <= (k) && (k) < hi)
#ifndef PROBE_REP
#define PROBE_REP -1
#endif
#ifndef PGA
#define PGA true
#endif
#ifndef WGM_P1
#define WGM_P1 2
#endif
#ifndef WGM_P6
#define WGM_P6 2
#endif
#ifndef PGS
#define PGS true
#endif
    if (args.sync_mode != 0) cg::this_grid().sync();
    volatile LAS unsigned* xst = (volatile LAS unsigned*)(lds + LDS_MISC);
    if (tid < 2) xst[tid] = 0u;
    __syncthreads();
    XcdBarrier xbar = xcd_barrier_post((unsigned*)(ws + WS_CTL), xst);
#define SEAM(k) do { if (IN(k) && IN((k) + 1)) { xcd_barrier(xbar); if (PROBE_REP == 99) { xcd_barrier(xbar); } } } while (0)
#define REPS(k) for (int rep_ = 0; rep_ < (PROBE_REP == (k) ? 2 : 1); ++rep_)
    bf16* Qb = (bf16*)args.out; bf16* Kb = (bf16*)args.out + (size_t)T * D;

    if (IN(0)) REPS(0) { p0_prologue(args, lds, G, tid, lane, wave); __syncthreads(); }
    SEAM(0);
    if (IN(1)) {
        pg8::Gemm g{(const bf16*)(ws + S_H), (const bf16*)(ws + WS_WIN), T, DIN, D}; pg8::StaticOrder S; S.init(T, DIN, G, (int)blockIdx.x, WGM_P1); S.rot = 4;
        pg8::EpiIn E{Qb, Kb, (bf16*)(ws + S_V), (bf16*)(ws + S_GS), (bf16*)(ws + S_U), (bf16*)(ws + S_GA), (bf16*)(ws + S_GB), (bf16*)(ws + S_LF), (const float*)(ws + WS_LB)};
        pg8::gemm_phase<pg8::EpiIn, pg8::StaticOrder, false, PGS>(lds, g, S, E);
    }
#if PROBE_REP == 1
    if (IN(1)) {
        pg8::Gemm g{(const bf16*)(ws + S_H), (const bf16*)(ws + WS_WIN), T, DIN, D}; pg8::StaticOrder S; S.init(T, DIN, G, (int)blockIdx.x, WGM_P1); S.rot = 4;
        pg8::EpiIn E{Qb, Kb, (bf16*)(ws + S_V), (bf16*)(ws + S_GS), (bf16*)(ws + S_U), (bf16*)(ws + S_GA), (bf16*)(ws + S_GB), (bf16*)(ws + S_LF), (const float*)(ws + WS_LB)};
        pg8::gemm_phase<pg8::EpiIn, pg8::StaticOrder, false, PGS>(lds, g, S, E);
    }
#endif
    SEAM(1);
    if (IN(2)) {
        const bool conv_first = ((blockIdx.x >> 3) & 1) != 0;
        if (!conv_first) { REPS(20) for (int u = blockIdx.x; u < 256; u += G) if ((u & 7) != 7) hgrn_unit<false>(lds, args, u, tid, lane, wave); }
        REPS(21) for (int t = blockIdx.x; t < T / 128; t += G) conv_tile(lds, args, t, tid, lane, wave);
        if (conv_first) { REPS(20) for (int u = blockIdx.x; u < 256; u += G) if ((u & 7) != 7) hgrn_unit<false>(lds, args, u, tid, lane, wave); }
    }
    SEAM(2);
    if (IN(3)) REPS(3) {
        for (int u = blockIdx.x; u < 256; u += G) hgrn_unit<true>(lds, args, u, tid, lane, wave);
        late_weights(args, lds, G, lane, wave); __syncthreads();
    }
    SEAM(3);
    if (IN(4)) {
        pg8::Gemm g{(const bf16*)(ws + S_OA), (const bf16*)(ws + WS_WA), T, D, 2 * D, D, 16, (long)((const char*)((const bf16*)args.out + (size_t)T * D) - (const char*)(ws + S_OA)), (long)(WS_WB - WS_WA)}; pg8::StaticOrder S; S.init(T, D, G, (int)blockIdx.x);
        pg8::EpiMerge E{(bf16*)(ws + S_MG), (const bf16*)(ws + S_GA), (const bf16*)(ws + S_GB)};
        pg8::gemm_phase<pg8::EpiMerge, pg8::StaticOrder, PGA, PGS>(lds, g, S, E);
    }
#if PROBE_REP == 4
    if (IN(4)) {
        pg8::Gemm g{(const bf16*)(ws + S_OA), (const bf16*)(ws + WS_WA), T, D, 2 * D, D, 16, (long)((const char*)((const bf16*)args.out + (size_t)T * D) - (const char*)(ws + S_OA)), (long)(WS_WB - WS_WA)}; pg8::StaticOrder S; S.init(T, D, G, (int)blockIdx.x);
        pg8::EpiMerge E{(bf16*)(ws + S_MG), (const bf16*)(ws + S_GA), (const bf16*)(ws + S_GB)};
        pg8::gemm_phase<pg8::EpiMerge, pg8::StaticOrder, PGA, PGS>(lds, g, S, E);
    }
#endif
    SEAM(4);
    if (IN(5)) {
        pg8::Gemm g{(const bf16*)(ws + S_MG), (const bf16*)(ws + WS_WO), T, D, D}; pg8::StaticOrder S; S.init(T, D, G, (int)blockIdx.x);
        pg8::EpiX1 E{(const bf16*)(ws + S_H), (const float*)(ws + WS_RINV), args.in[1], (bf16*)(ws + S_X1B), (float*)(ws + WS_SS)};
        pg8::gemm_phase<pg8::EpiX1, pg8::StaticOrder, PGA, PGS>(lds, g, S, E);
    }
#if PROBE_REP == 5
    if (IN(5)) {
        pg8::Gemm g{(const bf16*)(ws + S_MG), (const bf16*)(ws + WS_WO), T, D, D}; pg8::StaticOrder S; S.init(T, D, G, (int)blockIdx.x);
        pg8::EpiX1 E{(const bf16*)(ws + S_H), (const float*)(ws + WS_RINV), args.in[1], (bf16*)(ws + S_X1B), (float*)(ws + WS_SS)};
        pg8::gemm_phase<pg8::EpiX1, pg8::StaticOrder, PGA, PGS>(lds, g, S, E);
    }
#endif
    SEAM(5);
    if (IN(6)) {
        pg8::Gemm g{(const bf16*)(ws + S_X1B), (const bf16*)(ws + WS_WMI), T, FF, D}; pg8::StaticOrder S; S.init(T, FF, G, (int)blockIdx.x, WGM_P6);
        pg8::EpiZZ E{(bf16*)(ws + S_ZZ), (const float*)(ws + WS_SS)};
        pg8::gemm_phase<pg8::EpiZZ, pg8::StaticOrder, PGA, PGS>(lds, g, S, E);
    }
#if PROBE_REP == 6
    if (IN(6)) {
        pg8::Gemm g{(const bf16*)(ws + S_X1B), (const bf16*)(ws + WS_WMI), T, FF, D}; pg8::StaticOrder S; S.init(T, FF, G, (int)blockIdx.x, WGM_P6);
        pg8::EpiZZ E{(bf16*)(ws + S_ZZ), (const float*)(ws + WS_SS)};
        pg8::gemm_phase<pg8::EpiZZ, pg8::StaticOrder, PGA, PGS>(lds, g, S, E);
    }
#endif
    SEAM(6);
#if PROBE_REP == 7
    if (IN(7)) {
        pg8::Gemm g{(const bf16*)(ws + S_ZZ), (const bf16*)(ws + WS_WMO), T, D, FF}; pg8::StaticOrder S; S.init(T, D, G, (int)blockIdx.x);
        pg8::EpiDry E{(float*)(ws + WS_SS)};
        pg8::gemm_phase<pg8::EpiDry, pg8::StaticOrder, PGA, PGS>(lds, g, S, E);
    }
#endif
#if PROBE_REP == 61
    if (IN(6)) {
        pg8::Gemm g{(const bf16*)(ws + S_X1B), (const bf16*)(ws + WS_WMI), T, FF, D}; pg8::StaticOrder S; S.init(T, FF, G, (int)blockIdx.x, WGM_P6);
        pg8::EpiDry E{(float*)(ws + WS_SS)};
        pg8::gemm_phase<pg8::EpiDry, pg8::StaticOrder, PGA, PGS>(lds, g, S, E);
    }
#endif
    if (IN(7)) {
        pg8::Gemm g{(const bf16*)(ws + S_ZZ), (const bf16*)(ws + WS_WMO), T, D, FF}; pg8::StaticOrder S; S.init(T, D, G, (int)blockIdx.x);
        pg8::EpiX2 E{(const bf16*)(ws + S_X1B), args.out, args.in[15], (float*)(ws + WS_CTL + CTL_SS2), (unsigned*)(ws + WS_CTL + CTL_CNT)};
        pg8::gemm_phase<pg8::EpiX2, pg8::StaticOrder, PGA, PGS>(lds, g, S, E);
    }
#undef IN
#undef SEAM
}

extern "C" void kernel_launch(void* const* d_in, const int* in_sizes, int n_in, void* d_out, int out_size, void* d_ws, size_t ws_size, hipStream_t stream) {
    static int grid = 0;
    if (grid == 0) {
        int dev = 0, cus = 0, per_cu = 0;
        hipGetDevice(&dev); hipDeviceGetAttribute(&cus, hipDeviceAttributeMultiprocessorCount, dev);
        hipFuncSetAttribute((const void*)fwd_megakernel, hipFuncAttributeMaxDynamicSharedMemorySize, LDS_BYTES);
        hipOccupancyMaxActiveBlocksPerMultiprocessor(&per_cu, (const void*)fwd_megakernel, 512, LDS_BYTES);
        if (per_cu < 1) { fprintf(stderr, "kernel_launch: occupancy query says %d blocks per CU\n", per_cu); per_cu = 1; }
        grid = cus * per_cu; if (grid > 256) grid = 256;
        if (ws_size < WS_END) fprintf(stderr, "kernel_launch: workspace %zu < %zu needed\n", ws_size, (size_t)WS_END);
    }
    hipMemsetAsync((unsigned char*)d_ws + WS_CTL, 0, CTL_BYTES, stream);
    Args a{};
    for (int i = 0; i < 16; ++i) a.in[i] = (const float*)d_in[i];
    a.out = (float*)d_out; a.ws = (unsigned char*)d_ws;
#if MK_N_LAUNCHES == 1
    a.ph_lo = 0; a.ph_hi = NPHASES;
    void* kargs[] = {&a};
    hipError_t e = hipLaunchCooperativeKernel((const void*)fwd_megakernel, dim3(grid), dim3(512), kargs, LDS_BYTES, stream);
    if (e != hipSuccess) fprintf(stderr, "cooperative launch failed: %s (grid %d)\n", hipGetErrorString(e), grid);
#else
    for (int p = 0; p < NPHASES; ++p) { a.ph_lo = p; a.ph_hi = p + 1; hipLaunchKernelGGL(fwd_megakernel, dim3(grid), dim3(512), LDS_BYTES, stream, a); }
#endif
}
```
